# Optimizing an MI355X kernel written in HIP

```python
import math
import jax, jax.numpy as jnp
from jax import lax
import numpy as np

D_MODEL = 1024
BATCH = 4
SEQ = 4096
DEPTH = 4
DEC_BATCH = 128
DEC_SEQ = 4
PAST_LEN = 8192
PAGE_SIZE = 128

RET_HEADS = 4
RET_QK_DIM = D_MODEL // RET_HEADS
RET_V_DIM = 2 * RET_QK_DIM
RET_CHUNK = 128
SWA_HEAD_DIM = 64
SWA_Q_HEADS = D_MODEL // SWA_HEAD_DIM
SWA_KV_HEADS = 4
SWA_GROUP = SWA_Q_HEADS // SWA_KV_HEADS
WINDOW = 128
SWA_BLOCK = WINDOW
D_FF = 4 * D_MODEL
ROPE_THETA = 10000.0
EPS = 1e-6
NEG_INF = -1e30
N_RET = (DEPTH + 1) // 2
N_SWA = DEPTH // 2

kernel_name = "hybrid_retention_swa_sink_decoder_step"


def rms_norm(x, g):
    xf = x.astype(jnp.float32)
    y = xf * lax.rsqrt(jnp.mean(xf * xf, axis=-1, keepdims=True) + EPS)
    return (y * g.astype(jnp.float32)).astype(x.dtype)


def rope(x, pos):
    d = x.shape[-1]
    half = d // 2
    inv = ROPE_THETA ** (-jnp.arange(half, dtype=jnp.float32) / half)
    ang = pos.astype(jnp.float32)[:, None] * inv[None, :]
    cos = jnp.cos(ang)[:, None, :]
    sin = jnp.sin(ang)[:, None, :]
    xf = x.astype(jnp.float32)
    x1, x2 = xf[..., :half], xf[..., half:]
    return jnp.concatenate([x1 * cos - x2 * sin, x2 * cos + x1 * sin], axis=-1).astype(x.dtype)


def retention(h, s0, pos, w_in, w_out):
    B, T, _ = h.shape
    H, dk, dv = RET_HEADS, RET_QK_DIM, RET_V_DIM
    proj = (h @ w_in).astype(jnp.float32)
    q = proj[..., :H * dk].reshape(B, T, H, dk)
    k = proj[..., H * dk:2 * H * dk].reshape(B, T, H, dk)
    v = proj[..., 2 * H * dk:2 * H * dk + H * dv].reshape(B, T, H, dv)
    g = proj[..., 2 * H * dk + H * dv:]
    q = rope(q, pos)
    k = rope(k, pos) * (dk ** -0.5)
    C = RET_CHUNK if T % RET_CHUNK == 0 else T
    nc = T // C
    log_g = jnp.log1p(-jnp.exp2(-5.0 - jnp.arange(H, dtype=jnp.float32)))
    idx = jnp.arange(C, dtype=jnp.float32)
    diff = idx[:, None] - idx[None, :]
    dmat = jnp.where(diff >= 0, jnp.exp(jnp.maximum(diff, 0.0)[None] * log_g[:, None, None]), 0.0)
    q_dec = jnp.exp((idx + 1.0)[:, None] * log_g[None, :])
    k_dec = jnp.exp((C - 1.0 - idx)[:, None] * log_g[None, :])
    c_dec = jnp.exp(C * log_g)
    qc = q.reshape(B, nc, C, H, dk)
    kc = k.reshape(B, nc, C, H, dk)
    vc = v.reshape(B, nc, C, H, dv)
    scores = jnp.einsum('bnihd,bnjhd->bnhij', qc, kc) * dmat[None, None]
    intra = jnp.einsum('bnhij,bnjhe->bnihe', scores, vc)

    def step(S, xs):
        qi, ki, vi = xs
        cross = jnp.einsum('bihd,bhde->bihe', qi * q_dec[None, :, :, None], S)
        S = S * c_dec[None, :, None, None] + jnp.einsum('bjhd,bjhe->bhde', ki * k_dec[None, :, :, None], vi)
        return S, cross

    s_fin, cross = lax.scan(step, s0.astype(jnp.float32),
                            (qc.transpose(1, 0, 2, 3, 4), kc.transpose(1, 0, 2, 3, 4), vc.transpose(1, 0, 2, 3, 4)))
    o = (intra + cross.transpose(1, 0, 2, 3, 4)).reshape(B, T, H, dv)
    o = o * lax.rsqrt(jnp.mean(o * o, axis=-1, keepdims=True) + EPS)
    o = o.reshape(B, T, H * dv) * jax.nn.silu(g)
    return o.astype(h.dtype) @ w_out, s_fin


def sink_softmax(s, mask, sinks):
    s = jnp.where(mask, s, NEG_INF)
    sk = sinks.astype(jnp.float32)[:, :, None, None]
    m = jnp.maximum(jnp.max(s, axis=-1, keepdims=True), sk)
    p = jnp.exp(s - m)
    return p / (jnp.sum(p, axis=-1, keepdims=True) + jnp.exp(sk - m))


def swa_qkv(h, pos, w_qkv, q_norm, k_norm):
    B, T, _ = h.shape
    Hq, Hkv, dh = SWA_Q_HEADS, SWA_KV_HEADS, SWA_HEAD_DIM
    proj = h @ w_qkv
    q = proj[..., :Hq * dh].reshape(B, T, Hq, dh)
    k = proj[..., Hq * dh:(Hq + Hkv) * dh].reshape(B, T, Hkv, dh)
    v = proj[..., (Hq + Hkv) * dh:].reshape(B, T, Hkv, dh)
    q = rope(rms_norm(q, q_norm), pos)
    k = rope(rms_norm(k, k_norm), pos)
    return q.reshape(B, T, Hkv, SWA_GROUP, dh), k, v


def swa_prompt(h, pos, w_qkv, q_norm, k_norm, sinks, w_o):
    B, T, _ = h.shape
    q, k, v = swa_qkv(h, pos, w_qkv, q_norm, k_norm)
    nb = T // SWA_BLOCK
    qb = q.reshape(B, nb, SWA_BLOCK, SWA_KV_HEADS, SWA_GROUP, SWA_HEAD_DIM)
    kb = k.reshape(B, nb, SWA_BLOCK, SWA_KV_HEADS, SWA_HEAD_DIM)
    vb = v.reshape(B, nb, SWA_BLOCK, SWA_KV_HEADS, SWA_HEAD_DIM)
    shift = lambda a: jnp.concatenate([jnp.zeros_like(a[:, :1]), a[:, :-1]], axis=1)
    kk = jnp.concatenate([shift(kb), kb], axis=2)
    vv = jnp.concatenate([shift(vb), vb], axis=2)
    blk = jnp.arange(nb)[:, None]
    qpos = blk * SWA_BLOCK + jnp.arange(SWA_BLOCK)[None, :]
    kpos = (blk - 1) * SWA_BLOCK + jnp.arange(2 * SWA_BLOCK)[None, :]
    d = qpos[:, :, None] - kpos[:, None, :]
    mask = (d >= 0) & (d < WINDOW) & (kpos[:, None, :] >= 0)
    s = jnp.einsum('bnikgd,bnjkd->bnkgij', qb, kk).astype(jnp.float32) * (SWA_HEAD_DIM ** -0.5)
    p = sink_softmax(s, mask[None, :, None, None], sinks.reshape(SWA_KV_HEADS, SWA_GROUP))
    o = jnp.einsum('bnkgij,bnjkd->bnikgd', p.astype(vv.dtype), vv).reshape(B, T, SWA_Q_HEADS * SWA_HEAD_DIM)
    return o @ w_o, k[:, -WINDOW:], v[:, -WINDOW:]


def swa_sample(h, pos, cache_k, cache_v, w_qkv, q_norm, k_norm, sinks, w_o):
    B, T, _ = h.shape
    L = cache_k.shape[1]
    q, k, v = swa_qkv(h, pos, w_qkv, q_norm, k_norm)
    kk = jnp.concatenate([cache_k.astype(k.dtype), k], axis=1)
    vv = jnp.concatenate([cache_v.astype(v.dtype), v], axis=1)
    kpos = PAST_LEN - L + jnp.arange(L + T)
    d = pos[:, None] - kpos[None, :]
    mask = (d >= 0) & (d < WINDOW)
    s = jnp.einsum('btkgd,bskd->bkgts', q, kk).astype(jnp.float32) * (SWA_HEAD_DIM ** -0.5)
    p = sink_softmax(s, mask[None, None, None], sinks.reshape(SWA_KV_HEADS, SWA_GROUP))
    o = jnp.einsum('bkgts,bskd->btkgd', p.astype(vv.dtype), vv).reshape(B, T, SWA_Q_HEADS * SWA_HEAD_DIM)
    return o @ w_o, kk[:, -L:], vv[:, -L:]


def sq_relu_mlp(h, w_up, w_down):
    a = jax.nn.relu(h @ w_up)
    return (a * a) @ w_down


def setup_inputs(seed: int = 0) -> dict:
    key = jax.random.key(seed)
    ks = jax.random.split(key, 16)
    f32 = jnp.float32
    nrm = lambda k, shape, scale: jax.random.normal(k, shape, f32) * scale
    L = min(WINDOW, PAST_LEN)
    ret_in = 2 * RET_HEADS * RET_QK_DIM + 2 * RET_HEADS * RET_V_DIM
    swa_in = (SWA_Q_HEADS + 2 * SWA_KV_HEADS) * SWA_HEAD_DIM
    return {
        "x_prompt": nrm(ks[0], (BATCH, SEQ, D_MODEL), 1.0),
        "x_sample": nrm(ks[1], (DEC_BATCH, DEC_SEQ, D_MODEL), 1.0),
        "state_ret": nrm(ks[2], (N_RET, DEC_BATCH, RET_HEADS, RET_QK_DIM, RET_V_DIM), 0.5),
        "cache_swa_k": nrm(ks[3], (N_SWA, DEC_BATCH, L, SWA_KV_HEADS, SWA_HEAD_DIM), 1.0),
        "cache_swa_v": nrm(ks[4], (N_SWA, DEC_BATCH, L, SWA_KV_HEADS, SWA_HEAD_DIM), 1.0),
        "norm_mix": 1.0 + nrm(ks[5], (DEPTH, D_MODEL), 0.1),
        "norm_ffn": 1.0 + nrm(ks[6], (DEPTH, D_MODEL), 0.1),
        "ret_w_in": nrm(ks[7], (N_RET, D_MODEL, ret_in), D_MODEL ** -0.5),
        "ret_w_out": nrm(ks[8], (N_RET, RET_HEADS * RET_V_DIM, D_MODEL), (RET_HEADS * RET_V_DIM) ** -0.5),
        "swa_w_qkv": nrm(ks[9], (N_SWA, D_MODEL, swa_in), D_MODEL ** -0.5),
        "swa_q_norm": 1.0 + nrm(ks[10], (N_SWA, SWA_HEAD_DIM), 0.1),
        "swa_k_norm": 1.0 + nrm(ks[11], (N_SWA, SWA_HEAD_DIM), 0.1),
        "swa_sinks": nrm(ks[12], (N_SWA, SWA_Q_HEADS), 1.0),
        "swa_w_o": nrm(ks[13], (N_SWA, SWA_Q_HEADS * SWA_HEAD_DIM, D_MODEL), (SWA_Q_HEADS * SWA_HEAD_DIM) ** -0.5),
        "ffn_w_up": nrm(ks[14], (DEPTH, D_MODEL, D_FF), D_MODEL ** -0.5),
        "ffn_w_down": nrm(ks[15], (DEPTH, D_FF, D_MODEL), D_FF ** -0.5),
    }


def reference(x_prompt, x_sample, state_ret, cache_swa_k, cache_swa_v, norm_mix, norm_ffn,
              ret_w_in, ret_w_out, swa_w_qkv, swa_q_norm, swa_k_norm, swa_sinks, swa_w_o,
              ffn_w_up, ffn_w_down):
    pos_p = jnp.arange(SEQ)
    pos_s = PAST_LEN + jnp.arange(DEC_SEQ)
    xp, xs = x_prompt, x_sample
    ret_p, ret_s, kp, vp, ksmp, vsmp = [], [], [], [], [], []
    for i in range(DEPTH):
        hp = rms_norm(xp, norm_mix[i])
        hs = rms_norm(xs, norm_mix[i])
        if i % 2 == 0:
            r = i // 2
            s0 = jnp.zeros((BATCH, RET_HEADS, RET_QK_DIM, RET_V_DIM), jnp.float32)
            op, sp = retention(hp, s0, pos_p, ret_w_in[r], ret_w_out[r])
            os_, ss = retention(hs, state_ret[r], pos_s, ret_w_in[r], ret_w_out[r])
            ret_p.append(sp)
            ret_s.append(ss)
        else:
            a = i // 2
            op, k1, v1 = swa_prompt(hp, pos_p, swa_w_qkv[a], swa_q_norm[a], swa_k_norm[a], swa_sinks[a], swa_w_o[a])
            os_, k2, v2 = swa_sample(hs, pos_s, cache_swa_k[a], cache_swa_v[a], swa_w_qkv[a], swa_q_norm[a],
                                     swa_k_norm[a], swa_sinks[a], swa_w_o[a])
            kp.append(k1)
            vp.append(v1)
            ksmp.append(k2)
            vsmp.append(v2)
        xp = xp + op.astype(xp.dtype)
        xs = xs + os_.astype(xs.dtype)
        xp = xp + sq_relu_mlp(rms_norm(xp, norm_ffn[i]), ffn_w_up[i], ffn_w_down[i]).astype(xp.dtype)
        xs = xs + sq_relu_mlp(rms_norm(xs, norm_ffn[i]), ffn_w_up[i], ffn_w_down[i]).astype(xs.dtype)
    return (xp, xs, jnp.stack(ret_p), jnp.stack(kp), jnp.stack(vp), jnp.stack(ret_s), jnp.stack(ksmp), jnp.stack(vsmp))
```

```cpp
#include <hip/hip_runtime.h>
#include <hip/hip_cooperative_groups.h>
#include <cstdio>
#include <cstdint>
namespace cg = cooperative_groups;
namespace pg8 {
#define PG8_LAS __attribute__((address_space(3)))
typedef unsigned short bf16_t;
typedef short bf16x8 __attribute__((ext_vector_type(8)));
typedef float f32x4 __attribute__((ext_vector_type(4)));
typedef unsigned u32x4 __attribute__((ext_vector_type(4)));
constexpr int BM = 256, BK = 64, HALF = 128, HTB = HALF * BK * 2  , STAGE_BYTES = 8 * HTB, NXCD = 8, WGM = 8;

__host__ __device__ __forceinline__ int lds_byte(int r, int c) { const int st = (r >> 4) * 2 + (c >> 5), rr = r & 15, cc = c & 31, ob = rr * 64 + cc * 2; return st * 1024 + (ob ^ (((ob >> 9) & 1) << 5)); }
__host__ __device__ __forceinline__ void stage_rc(int b, int& R, int& C) { const int st = b / 1024, sb = b % 1024, swz = sb ^ (((sb >> 9) & 1) << 5); R = (st >> 1) * 16 + swz / 64; C = (st & 1) * 32 + (swz % 64) / 2; }
__host__ __device__ __forceinline__ int perm32(int rho) { const int n = rho >> 4, i = rho & 15; return 8 * (i >> 2) + 4 * n + (i & 3); }

struct Unit { int pm, pn; };
struct Gemm { const bf16_t* A; const bf16_t* Bt; int M, N, K; };

struct StaticOrder {
    int nM, nN, nwg, G, c;
    __host__ __device__ void init(int M, int N, int G_, int c_) { nM = M / BM; nN = N / BM; nwg = nM * nN; G = G_; c = c_; }
    __host__ __device__ bool next(int i, Unit& u) const {
        const long L = (long)i * G + c; if (L >= nwg) return false;
        int wgid = (int)L; { const int q = nwg / NXCD, r = nwg % NXCD, xcd = wgid % NXCD, off = wgid / NXCD; wgid = (xcd < r ? xcd * (q + 1) : r * (q + 1) + (xcd - r) * q) + off; }
        const int nig = WGM * nN, gid = wgid / nig, fm = gid * WGM, gsz = (nM - fm) < WGM ? (nM - fm) : WGM;
        u.pm = fm + ((wgid % nig) % gsz); u.pn = (wgid % nig) / gsz; return true;
    }
    __device__ __forceinline__ void a_ready(const Unit&) const {}
    __device__ __forceinline__ void done(const Unit&) const {}
};

__device__ __forceinline__ unsigned cvt_pk_bf16(float lo, float hi) { typedef float f2 __attribute__((ext_vector_type(2))); typedef __bf16 b2 __attribute__((ext_vector_type(2))); f2 v = {lo, hi}; b2 b = __builtin_convertvector(v, b2); return __builtin_bit_cast(unsigned, b); }
template <class Epi, class Sched, bool ALIGN_EPI = false, bool SP2 = false>
__device__ __forceinline__ void gemm_phase(PG8_LAS unsigned char* lds, const Gemm g, const Sched& S, const Epi& E) {
    int tid = threadIdx.x; asm volatile("" : "+v"(tid));
    const int wid = __builtin_amdgcn_readfirstlane(tid >> 6), lane = tid & 63, wr = wid >> 2, wc = wid & 3, fr = lane & 15, fq = lane >> 4;
    const int K = g.K, nt = K / BK;
    unsigned voffA[2], voffB[2];
#pragma unroll
    for (int i = 0; i < 2; ++i) { int R, C; stage_rc(tid * 16 + i * 8192, R, C); const int Rb = Epi::PERM ? ((R & ~31) + perm32(R & 31)) : R;
        voffA[i] = (unsigned)(R * K + C) * 2u; voffB[i] = (unsigned)(Rb * K + C) * 2u; }
    const size_t kstep = (size_t)(BK * 2);
    const size_t hstep = (size_t)HALF * K * 2;
    const size_t tstep = 2 * hstep;
    const unsigned ldsw = (unsigned)wid * 1024u;
    const int aoff = lds_byte(wr * 64 + fr, fq * 8), boff = lds_byte(wc * 32 + fr, fq * 8);
#define PG8_SA(b, h) (((b) * 2 + (h)) * HTB)
#define PG8_SB(b, h) ((4 + (b) * 2 + (h)) * HTB)
#define PG8_STAGE(bufoff, gbase, voff) do { _Pragma("unroll") for (int _i = 0; _i < 2; ++_i) \
        __builtin_amdgcn_global_load_lds((const unsigned*)((const char*)(gbase) + (voff)[_i]), (PG8_LAS unsigned*)(lds + (bufoff) + ldsw + _i * 8192), 16, 0, 0); } while (0)
#define PG8_LDA(dst, b, h) do { _Pragma("unroll") for (int m = 0; m < 4; ++m) _Pragma("unroll") for (int k = 0; k < 2; ++k) dst[m][k] = *(const PG8_LAS bf16x8*)(lds + PG8_SA(b, h) + aoff + m * 2048 + k * 1024); } while (0)
#define PG8_LDB(dst, b, h) do { _Pragma("unroll") for (int n = 0; n < 2; ++n) _Pragma("unroll") for (int k = 0; k < 2; ++k) dst[n][k] = *(const PG8_LAS bf16x8*)(lds + PG8_SB(b, h) + boff + n * 2048 + k * 1024); } while (0)
#define PG8_MMA(ai, bj, At, Bt) do { __builtin_amdgcn_s_setprio(1); _Pragma("unroll") for (int m = 0; m < 4; ++m) _Pragma("unroll") for (int n = 0; n < 2; ++n) _Pragma("unroll") for (int k = 0; k < 2; ++k) \
        acc[ai][bj][m][n] = __builtin_amdgcn_mfma_f32_16x16x32_bf16(Bt[n][k], At[m][k], acc[ai][bj][m][n], 0, 0, 0); __builtin_amdgcn_s_setprio(0); } while (0)
#define PG8_WAIT_V(n) asm volatile("s_waitcnt vmcnt(" #n ")" ::: "memory")
#define PG8_WAIT_L(n) asm volatile("s_waitcnt lgkmcnt(" #n ")" ::: "memory")
#define PG8_BAR __builtin_amdgcn_s_barrier()
#define PG8_SCHED __builtin_amdgcn_sched_barrier(0)
    Unit cur, nxt; int ui = 0;
    if (!S.next(0, cur)) return;
    f32x4 acc[2][2][4][2];
#pragma unroll
    for (int a = 0; a < 2; ++a)
#pragma unroll
        for (int b = 0; b < 2; ++b)
#pragma unroll
            for (int m = 0; m < 4; ++m)
#pragma unroll
                for (int n = 0; n < 2; ++n) acc[a][b][m][n] = (f32x4){0.f, 0.f, 0.f, 0.f};
    bf16x8 At[4][2], B0[2][2], B1[2][2];
    const char* cA = (const char*)g.A + (size_t)cur.pm * tstep; const char* cB = (const char*)g.Bt + (size_t)cur.pn * tstep;
    S.a_ready(cur);
    if constexpr (SP2) {
        PG8_STAGE(PG8_SB(0, 0), cB, voffB); PG8_STAGE(PG8_SB(0, 1), cB + hstep, voffB); PG8_STAGE(PG8_SA(0, 0), cA, voffA); PG8_STAGE(PG8_SA(0, 1), cA + hstep, voffA);
        if (wr == 1) PG8_BAR;
        PG8_WAIT_V(2); PG8_BAR;
        PG8_STAGE(PG8_SB(1, 0), cB + kstep, voffB); PG8_STAGE(PG8_SA(1, 0), cA + kstep, voffA); PG8_STAGE(PG8_SB(1, 1), cB + hstep + kstep, voffB);
        PG8_WAIT_V(6); PG8_BAR;
    } else {
        PG8_STAGE(PG8_SB(0, 0), cB, voffB); PG8_STAGE(PG8_SA(0, 0), cA, voffA); PG8_STAGE(PG8_SB(0, 1), cB + hstep, voffB); PG8_STAGE(PG8_SA(0, 1), cA + hstep, voffA);
        if (wr == 1) PG8_BAR;
        PG8_WAIT_V(4); PG8_BAR;
        PG8_STAGE(PG8_SB(1, 0), cB + kstep, voffB); PG8_STAGE(PG8_SA(1, 0), cA + kstep, voffA); PG8_STAGE(PG8_SB(1, 1), cB + hstep + kstep, voffB);
        PG8_WAIT_V(6); PG8_BAR;
    }
    for (;;) {
        const bool has_next = S.next(ui + 1, nxt);
        const char* nA = has_next ? (const char*)g.A + (size_t)nxt.pm * tstep : cA; const char* nB = has_next ? (const char*)g.Bt + (size_t)nxt.pn * tstep : cB;
        for (int t = 0; t < nt; t += 2) {
            const bool last = (t == nt - 2);
            const char* a1 = cA + (size_t)(t + 1) * kstep;
            const char* a2 = last ? nA : cA + (size_t)(t + 2) * kstep; const char* b2 = last ? nB : cB + (size_t)(t + 2) * kstep;
            const char* a3 = a2 + kstep; const char* b3 = b2 + kstep;
            if (last && has_next) S.a_ready(nxt);
            if constexpr (SP2) {
            PG8_LDB(B0, 0, 0); PG8_LDB(B1, 0, 1); PG8_SCHED; PG8_LDA(At, 0, 0); PG8_STAGE(PG8_SA(1, 1), a1 + hstep, voffA);
            PG8_WAIT_V(8); PG8_WAIT_L(0); PG8_BAR; PG8_MMA(0, 0, At, B0); PG8_MMA(0, 1, At, B1); PG8_BAR; PG8_SCHED;
            PG8_LDA(At, 0, 1); PG8_STAGE(PG8_SB(0, 0), b2, voffB); PG8_STAGE(PG8_SB(0, 1), b2 + hstep, voffB); PG8_STAGE(PG8_SA(0, 0), a2, voffA);
            PG8_WAIT_V(8); PG8_WAIT_L(0); PG8_BAR; PG8_MMA(1, 0, At, B0); PG8_MMA(1, 1, At, B1); PG8_BAR; PG8_SCHED;
            PG8_LDB(B0, 1, 0); PG8_LDB(B1, 1, 1); PG8_SCHED; PG8_LDA(At, 1, 0); PG8_STAGE(PG8_SA(0, 1), a2 + hstep, voffA);
            PG8_WAIT_V(8); PG8_WAIT_L(0); PG8_BAR; PG8_MMA(0, 0, At, B0); PG8_MMA(0, 1, At, B1); PG8_BAR; PG8_SCHED;
            PG8_LDA(At, 1, 1); PG8_STAGE(PG8_SB(1, 0), b3, voffB); PG8_STAGE(PG8_SB(1, 1), b3 + hstep, voffB); PG8_STAGE(PG8_SA(1, 0), a3, voffA);
            PG8_WAIT_V(8); PG8_WAIT_L(0); PG8_BAR; PG8_MMA(1, 0, At, B0); PG8_MMA(1, 1, At, B1); PG8_BAR; PG8_SCHED;
            } else {
            PG8_LDB(B0, 0, 0); PG8_SCHED; PG8_LDA(At, 0, 0); PG8_STAGE(PG8_SA(1, 1), a1 + hstep, voffA);
            PG8_WAIT_L(8); PG8_BAR; PG8_WAIT_L(0); PG8_MMA(0, 0, At, B0); PG8_BAR; PG8_SCHED;
            PG8_LDB(B1, 0, 1); PG8_STAGE(PG8_SB(0, 0), b2, voffB);
            PG8_BAR; PG8_WAIT_L(0); PG8_MMA(0, 1, At, B1); PG8_BAR;
            PG8_LDA(At, 0, 1); PG8_STAGE(PG8_SA(0, 0), a2, voffA);
            PG8_BAR; PG8_WAIT_L(0); PG8_MMA(1, 0, At, B0); PG8_BAR; PG8_SCHED;
            PG8_STAGE(PG8_SB(0, 1), b2 + hstep, voffB);
            PG8_WAIT_V(6); PG8_BAR; PG8_MMA(1, 1, At, B1); PG8_BAR;
            PG8_LDB(B0, 1, 0); PG8_SCHED; PG8_LDA(At, 1, 0); PG8_STAGE(PG8_SA(0, 1), a2 + hstep, voffA);
            PG8_WAIT_L(8); PG8_BAR; PG8_WAIT_L(0); PG8_MMA(0, 0, At, B0); PG8_BAR; PG8_SCHED;
            PG8_LDB(B1, 1, 1); PG8_STAGE(PG8_SB(1, 0), b3, voffB);
            PG8_BAR; PG8_WAIT_L(0); PG8_MMA(0, 1, At, B1); PG8_BAR;
            PG8_LDA(At, 1, 1); PG8_STAGE(PG8_SA(1, 0), a3, voffA);
            PG8_BAR; PG8_WAIT_L(0); PG8_MMA(1, 0, At, B0); PG8_BAR; PG8_SCHED;
            PG8_STAGE(PG8_SB(1, 1), b3 + hstep, voffB);
            PG8_WAIT_V(6); PG8_BAR; PG8_MMA(1, 1, At, B1); PG8_BAR;
            }
        }
        if constexpr (ALIGN_EPI) { if (wr == 0) PG8_BAR; }
        if constexpr (!Epi::AFTER_DRAIN) { E(acc, cur, wr, wc, fr, fq); S.done(cur); }
        if (!has_next) break;
#pragma unroll
        for (int a = 0; a < 2; ++a)
#pragma unroll
            for (int b = 0; b < 2; ++b)
#pragma unroll
                for (int m = 0; m < 4; ++m)
#pragma unroll
                    for (int n = 0; n < 2; ++n) acc[a][b][m][n] = (f32x4){0.f, 0.f, 0.f, 0.f};
        cur = nxt; cA = nA; cB = nB; ++ui;
        if constexpr (ALIGN_EPI) { if (wr == 1) PG8_BAR; }
    }
    PG8_WAIT_V(0);
    if constexpr (!ALIGN_EPI) { if (wr == 0) PG8_BAR; }
    PG8_BAR;
    if constexpr (Epi::AFTER_DRAIN) { E.fused(acc, cur, wr, wc, fr, fq, lds, wid, lane); S.done(cur); }
#undef PG8_SA
#undef PG8_SB
#undef PG8_STAGE
#undef PG8_LDA
#undef PG8_LDB
#undef PG8_MMA
#undef PG8_WAIT_V
#undef PG8_WAIT_L
#undef PG8_BAR
#undef PG8_SCHED
}
}

#define LAS __attribute__((address_space(3)))
typedef unsigned short bf16;
typedef float f32x4 __attribute__((ext_vector_type(4)));
typedef unsigned u32x4 __attribute__((ext_vector_type(4)));
typedef unsigned u32x2 __attribute__((ext_vector_type(2)));
typedef short bf16x8 __attribute__((ext_vector_type(8)));
typedef short s16x4 __attribute__((ext_vector_type(4)));
typedef short v4i16_t __attribute__((ext_vector_type(4)));

constexpr int D = 1024, SEQ = 4096, NB = 4, MP = NB * SEQ, DECB = 128, DECT = 4, MS = DECB * DECT, M = MP + MS;
constexpr int PAST = 8192;
constexpr int RH = 4, RDK = 256, RDV = 512, RN = 6144, RO = 2048;
constexpr int HKV = 4, DH = 64, SN = 1536, WIN = 128;
constexpr int FF = 4096;
constexpr float EPS = 1e-6f;
constexpr int NPOS = SEQ + DECT;
constexpr int NT = 512;
constexpr int LDS_BYTES = 147456;
#ifndef REP_RET
#define REP_RET 1
#endif
#ifndef REP_ATTN
#define REP_ATTN 1
#endif
#ifndef REP_P0
#define REP_P0 1
#endif

constexpr size_t O_YS = (size_t)MP * D, O_SRP = O_YS + (size_t)MS * D, SRP_L = (size_t)NB * RH * RDK * RDV;
constexpr size_t O_CKP = O_SRP + 2 * SRP_L, CP_L = (size_t)NB * WIN * HKV * DH, O_CVP = O_CKP + 2 * CP_L;
constexpr size_t O_SRS = O_CVP + 2 * CP_L, SRS_L = (size_t)DECB * RH * RDK * RDV;
constexpr size_t O_CKS = O_SRS + 2 * SRS_L, CS_L = (size_t)DECB * WIN * HKV * DH, O_CVS = O_CKS + 2 * CS_L;
constexpr size_t MiB = 1u << 20;
constexpr size_t WS_RIN = 1 * MiB, WS_ROUT = 25 * MiB, WS_QKV = 33 * MiB, WS_WO = 39 * MiB, WS_UP = 43 * MiB, WS_DN = 75 * MiB;
constexpr size_t WS_XB = 107 * MiB, WS_SSQ = 140 * MiB, WS_GN = 142 * MiB, WS_TABR = 145 * MiB, WS_TABS = 150 * MiB;
constexpr size_t WS_PROJ = 152 * MiB, WS_OG = 350 * MiB, WS_ACT = 416 * MiB, WS_END = 548 * MiB;

__device__ __forceinline__ unsigned pk2(float lo, float hi) { return pg8::cvt_pk_bf16(lo, hi); }
__device__ __forceinline__ float bflo(unsigned u) { return __uint_as_float(u << 16); }
__device__ __forceinline__ float bfhi(unsigned u) { return __uint_as_float(u & 0xffff0000u); }
__device__ __forceinline__ float bf2f(bf16 b) { return __uint_as_float(((unsigned)b) << 16); }
__device__ __forceinline__ float wave_sum(float v) {
#pragma unroll
    for (int o = 1; o < 64; o <<= 1) v += __shfl_xor(v, o);
    return v;
}
__device__ __forceinline__ float uni(float x) { return __uint_as_float(__builtin_amdgcn_readfirstlane(__float_as_uint(x))); }
__device__ __forceinline__ float dot4(f32x4 a) { return (a.x * a.x + a.y * a.y) + (a.z * a.z + a.w * a.w); }
__device__ __forceinline__ s16x4 vtr(LAS const unsigned char* p) { return __builtin_bit_cast(s16x4, __builtin_amdgcn_ds_read_tr16_b64_v4i16((LAS v4i16_t*)p)); }
__device__ __forceinline__ bf16x8 cat8(s16x4 lo, s16x4 hi) { return (bf16x8){lo[0], lo[1], lo[2], lo[3], hi[0], hi[1], hi[2], hi[3]}; }
__device__ __forceinline__ bf16x8 packp(f32x4 a, f32x4 b) { u32x4 w; w.x = pk2(a.x, a.y); w.y = pk2(a.z, a.w); w.z = pk2(b.x, b.y); w.w = pk2(b.z, b.w); return __builtin_bit_cast(bf16x8, w); }
#define MFMA16(a, b, c) __builtin_amdgcn_mfma_f32_16x16x32_bf16(a, b, c, 0, 0, 0)

__device__ __forceinline__ float row_rs(const float* SSQ, int row) {
    const f32x4* p = (const f32x4*)(SSQ + (size_t)row * 16);
    const f32x4 a = p[0], b = p[1], c = p[2], d = p[3];
    const float s = (((a.x + a.y) + (a.z + a.w)) + ((b.x + b.y) + (b.z + b.w))) + (((c.x + c.y) + (c.z + c.w)) + ((d.x + d.y) + (d.z + d.w)));
    return rsqrtf(s * (1.0f / 1024.0f) + EPS);
}
__device__ __forceinline__ void row_rs8(const float* SSQ, int row_base  , int fq, float (&rs)[2][4]) {
    f32x4 p[2][4];
#pragma unroll
    for (int ai = 0; ai < 2; ++ai)
#pragma unroll
        for (int m = 0; m < 4; ++m) p[ai][m] = *(const f32x4*)(SSQ + (size_t)(row_base + ai * 128 + m * 16) * 16 + 4 * fq);
#pragma unroll
    for (int ai = 0; ai < 2; ++ai)
#pragma unroll
        for (int m = 0; m < 4; ++m) {
            float s = (p[ai][m].x + p[ai][m].y) + (p[ai][m].z + p[ai][m].w);
            s += __shfl_xor(s, 16); s += __shfl_xor(s, 32);
            rs[ai][m] = rsqrtf(s * (1.0f / 1024.0f) + EPS);
        }
}
__device__ __forceinline__ int pos_index(int row) { return row < MP ? (row & (SEQ - 1)) : SEQ + ((row - MP) & 3); }

struct EpiRes {
    static constexpr bool PERM = true, AFTER_DRAIN = false;
    const float* Xin; float* X; bf16* XB; float* SSQ;
    __device__ __forceinline__ void operator()(const pg8::f32x4 (&acc)[2][2][4][2], const pg8::Unit& u, int wr, int wc, int fr, int fq) const {
#pragma unroll
        for (int ai = 0; ai < 2; ++ai)
#pragma unroll
            for (int m = 0; m < 4; ++m) {
                const int row = u.pm * 256 + ai * 128 + wr * 64 + m * 16 + fr;
                float ss = 0.f;
#pragma unroll
                for (int bj = 0; bj < 2; ++bj) {
                    const int col = u.pn * 256 + bj * 128 + wc * 32 + 8 * fq;
                    float* xp = X + (size_t)row * D + col; const float* xi = Xin + (size_t)row * D + col;
                    const f32x4 a = *(const f32x4*)xi + acc[ai][bj][m][0], b = *(const f32x4*)(xi + 4) + acc[ai][bj][m][1];
                    *(f32x4*)xp = a; *(f32x4*)(xp + 4) = b;
                    ss += dot4(a) + dot4(b);
                    u32x4 w; w.x = pk2(a.x, a.y); w.y = pk2(a.z, a.w); w.z = pk2(b.x, b.y); w.w = pk2(b.z, b.w);
                    *(u32x4*)(XB + (size_t)row * D + col) = w;
                }
                ss += __shfl_xor(ss, 16); ss += __shfl_xor(ss, 32);
                if (fq == 0) SSQ[(size_t)row * 16 + u.pn * 4 + wc] = ss;
                if (m & 1) asm volatile("" ::: "memory");
            }
    }
};
struct EpiUp {
    static constexpr bool PERM = true, AFTER_DRAIN = false;
    bf16* ACT; const float* SSQ;
    __device__ __forceinline__ void operator()(const pg8::f32x4 (&acc)[2][2][4][2], const pg8::Unit& u, int wr, int wc, int fr, int fq) const {
        const int rb = u.pm * 256 + wr * 64 + fr;
        float rsv[2][4]; row_rs8(SSQ, rb, fq, rsv);
#pragma unroll
        for (int ai = 0; ai < 2; ++ai)
#pragma unroll
            for (int m = 0; m < 4; ++m) {
                const int row = rb + ai * 128 + m * 16;
                const float rs = rsv[ai][m];
#pragma unroll
                for (int bj = 0; bj < 2; ++bj) {
                    const int col = u.pn * 256 + bj * 128 + wc * 32 + 8 * fq;
                    f32x4 a = acc[ai][bj][m][0] * rs, b = acc[ai][bj][m][1] * rs;
                    a = __builtin_elementwise_max(a, (f32x4){0.f, 0.f, 0.f, 0.f}); b = __builtin_elementwise_max(b, (f32x4){0.f, 0.f, 0.f, 0.f});
                    a = a * a; b = b * b;
                    u32x4 w; w.x = pk2(a.x, a.y); w.y = pk2(a.z, a.w); w.z = pk2(b.x, b.y); w.w = pk2(b.z, b.w);
                    *(u32x4*)(ACT + (size_t)row * FF + col) = w;
                }
            }
    }
};
__device__ __forceinline__ void rope4(const f32x4 x1, const f32x4 x2, const f32x4 t0, const f32x4 t1, f32x4& o1, f32x4& o2) {
    o1.x = x1.x * t0.x - x2.x * t0.y; o2.x = x2.x * t0.x + x1.x * t0.y;
    o1.y = x1.y * t0.z - x2.y * t0.w; o2.y = x2.y * t0.z + x1.y * t0.w;
    o1.z = x1.z * t1.x - x2.z * t1.y; o2.z = x2.z * t1.x + x1.z * t1.y;
    o1.w = x1.w * t1.z - x2.w * t1.w; o2.w = x2.w * t1.z + x1.w * t1.w;
}
__device__ __forceinline__ float silu1(float v) { return v / (1.0f + __expf(-v)); }
struct EpiRetIn {
    static constexpr bool PERM = true, AFTER_DRAIN = false;
    bf16* P; const float* SSQ; const float* TAB; int row_off;
    __device__ __forceinline__ void operator()(const pg8::f32x4 (&acc)[2][2][4][2], const pg8::Unit& u, int wr, int wc, int fr, int fq) const {
        const int pn = u.pn;
        const int rb = row_off + u.pm * 256 + wr * 64 + fr;
        float rsv[2][4]; row_rs8(SSQ, rb, fq, rsv);
#pragma unroll
        for (int ai = 0; ai < 2; ++ai) {
            if (pn < 8) {
#pragma unroll
                for (int mh = 0; mh < 2; ++mh) {
                f32x4 tb[4][4];
#pragma unroll
                for (int m = 2 * mh; m < 2 * mh + 2; ++m) { const f32x4* tp = (const f32x4*)(TAB + ((size_t)pos_index(rb + ai * 128 + m * 16) * 128 + wc * 32 + 8 * fq) * 2);
#pragma unroll
                    for (int q = 0; q < 4; ++q) tb[m][q] = tp[q]; }
#pragma unroll
                for (int m = 2 * mh; m < 2 * mh + 2; ++m) {
                    const int row = rb + ai * 128 + m * 16;
                    const float sc = pn >= 4 ? rsv[ai][m] * 0.0625f : rsv[ai][m];
                    bf16* prow = P + (size_t)row * RN + pn * 256 + wc * 32 + 8 * fq;
                    u32x4 w1, w2;
#pragma unroll
                    for (int n = 0; n < 2; ++n) {
                        f32x4 o1, o2; rope4(acc[ai][0][m][n] * sc, acc[ai][1][m][n] * sc, tb[m][2 * n], tb[m][2 * n + 1], o1, o2);
                        w1[2 * n] = pk2(o1.x, o1.y); w1[2 * n + 1] = pk2(o1.z, o1.w); w2[2 * n] = pk2(o2.x, o2.y); w2[2 * n + 1] = pk2(o2.z, o2.w);
                    }
                    *(u32x4*)prow = w1; *(u32x4*)(prow + 128) = w2;
                }
                asm volatile("" ::: "memory");
                }
            } else {
#pragma unroll
                for (int m = 0; m < 4; ++m) {
                    const int row = rb + ai * 128 + m * 16;
                    const float rs = rsv[ai][m];
                    bf16* prow = P + (size_t)row * RN + pn * 256 + wc * 32 + 8 * fq;
#pragma unroll
                    for (int bj = 0; bj < 2; ++bj) {
                        f32x4 a = acc[ai][bj][m][0] * rs, b = acc[ai][bj][m][1] * rs;
                        if (pn >= 16) { a.x = silu1(a.x); a.y = silu1(a.y); a.z = silu1(a.z); a.w = silu1(a.w); b.x = silu1(b.x); b.y = silu1(b.y); b.z = silu1(b.z); b.w = silu1(b.w); }
                        u32x4 w; w.x = pk2(a.x, a.y); w.y = pk2(a.z, a.w); w.z = pk2(b.x, b.y); w.w = pk2(b.z, b.w);
                        *(u32x4*)(prow + bj * 128) = w;
                    }
                }
            }
            asm volatile("" ::: "memory");
        }
    }
};
struct EpiSwaQkv {
    static constexpr bool PERM = true, AFTER_DRAIN = false;
    bf16* P; const float* SSQ; const float* TAB; const float* qn; const float* kn; float* ckp; float* cvp; float* cks; float* cvs;
    __device__ __forceinline__ float* cache_dst(float* cp, float* cs, int row, int kvh) const {
        if (row < MP) { const int t = row & (SEQ - 1); if (t < SEQ - WIN) return nullptr; return cp + (((size_t)(row >> 12) * WIN + (t - (SEQ - WIN))) * HKV + kvh) * DH; }
        const int rr = row - MP; return cs + (((size_t)(rr >> 2) * WIN + (WIN - DECT) + (rr & 3)) * HKV + kvh) * DH;
    }
    __device__ __forceinline__ void operator()(const pg8::f32x4 (&acc)[2][2][4][2], const pg8::Unit& u, int wr, int wc, int fr, int fq) const {
        const int pn = u.pn;
        float rsv[2][4]; row_rs8(SSQ, u.pm * 256 + wr * 64 + fr, fq, rsv);
        if (pn < 5) {
            const float* nw = pn < 4 ? qn : kn;
            f32x4 nwv[2][2];
#pragma unroll
            for (int bj = 0; bj < 2; ++bj)
#pragma unroll
                for (int n = 0; n < 2; ++n) nwv[bj][n] = *(const f32x4*)(nw + 32 * bj + 8 * fq + 4 * n);
#pragma unroll
            for (int ai = 0; ai < 2; ++ai)
#pragma unroll
                for (int m = 0; m < 4; ++m) {
                    const int row = u.pm * 256 + ai * 128 + wr * 64 + m * 16 + fr;
                    const float rs = rsv[ai][m];
                    f32x4 x[2][2]; float ss = 0.f;
#pragma unroll
                    for (int bj = 0; bj < 2; ++bj)
#pragma unroll
                        for (int n = 0; n < 2; ++n) { x[bj][n] = acc[ai][bj][m][n] * rs; ss += dot4(x[bj][n]); }
                    ss += __shfl_xor(ss, 16); ss += __shfl_xor(ss, 32);
                    const float r = rsqrtf(ss * (1.0f / 64.0f) + EPS);
                    const f32x4* tp = (const f32x4*)(TAB + ((size_t)pos_index(row) * 32 + 8 * fq) * 2);
                    u32x4 w1, w2; f32x4 o1[2], o2[2];
#pragma unroll
                    for (int n = 0; n < 2; ++n) {
                        rope4(x[0][n] * r * nwv[0][n], x[1][n] * r * nwv[1][n], tp[2 * n], tp[2 * n + 1], o1[n], o2[n]);
                        w1[2 * n] = pk2(o1[n].x, o1[n].y); w1[2 * n + 1] = pk2(o1[n].z, o1[n].w); w2[2 * n] = pk2(o2[n].x, o2[n].y); w2[2 * n + 1] = pk2(o2[n].z, o2[n].w);
                    }
                    bf16* prow = P + (size_t)row * SN + pn * 256 + wc * 64 + 8 * fq;
                    *(u32x4*)prow = w1; *(u32x4*)(prow + 32) = w2;
                    if (pn == 4) {
                        float* dst = cache_dst(ckp, cks, row, wc);
                        if (dst) { dst += 8 * fq; *(f32x4*)dst = o1[0]; *(f32x4*)(dst + 4) = o1[1]; *(f32x4*)(dst + 32) = o2[0]; *(f32x4*)(dst + 36) = o2[1]; }
                    }
                    if (m & 1) asm volatile("" ::: "memory");
                }
        } else {
#pragma unroll
            for (int ai = 0; ai < 2; ++ai)
#pragma unroll
                for (int m = 0; m < 4; ++m) {
                    const int row = u.pm * 256 + ai * 128 + wr * 64 + m * 16 + fr;
                    const float rs = rsv[ai][m];
#pragma unroll
                    for (int bj = 0; bj < 2; ++bj) {
                        const f32x4 a = acc[ai][bj][m][0] * rs, b = acc[ai][bj][m][1] * rs;
                        u32x4 w; w.x = pk2(a.x, a.y); w.y = pk2(a.z, a.w); w.z = pk2(b.x, b.y); w.w = pk2(b.z, b.w);
                        *(u32x4*)(P + (size_t)row * SN + 1280 + bj * 128 + wc * 32 + 8 * fq) = w;
                        float* dst = cache_dst(cvp, cvs, row, 2 * bj + (wc >> 1));
                        if (dst) { dst += 32 * (wc & 1) + 8 * fq; *(f32x4*)dst = a; *(f32x4*)(dst + 4) = b; }
                    }
                    asm volatile("" ::: "memory");
                }
        }
    }
};

#define XB_TMO      128
#define XB_XCNT(j)  (256  + 64 * (j))
#define XB_XSUB(j)  (1280 + 64 * (j))
#define XB_XGEN(j)  (2304 + 64 * (j))
#define XB_TOP      3328
#define XB_TOPGEN   3392
#define XCD_BAR_WORDS 3456
#define XB_SPIN_CAP (1u << 18)

__device__ __forceinline__ unsigned xb_ld(unsigned* p)              { return __hip_atomic_load(p, __ATOMIC_RELAXED, __HIP_MEMORY_SCOPE_AGENT); }
__device__ __forceinline__ unsigned xb_add(unsigned* p, unsigned v) { return __hip_atomic_fetch_add(p, v, __ATOMIC_RELAXED, __HIP_MEMORY_SCOPE_AGENT); }
__device__ __forceinline__ unsigned xb_xcc_id() { return (unsigned)__builtin_amdgcn_s_getreg((3 << 11) | 20) & 0xFu; }
#define XB_SPIN(cond, bar) do { unsigned _sp = 0; while (cond) { __builtin_amdgcn_s_sleep(1); \
    if ((++_sp & 255u) == 0u) { if (xb_ld(&(bar)[XB_TMO])) break; if (_sp > XB_SPIN_CAP) { atomicAdd(&(bar)[XB_TMO], 1u); break; } } } } while (0)

struct XcdBarrier {
    unsigned* bar; unsigned x;
    volatile LAS unsigned* st;
};

__device__ __forceinline__ XcdBarrier xcd_barrier_post(unsigned* bar, volatile LAS unsigned* st) {
    XcdBarrier b; b.bar = bar; b.x = xb_xcc_id(); b.st = st;
    if (threadIdx.x == 0) (void)xb_add(&bar[XB_XCNT(b.x)], 1u);
    return b;
}
__device__ __forceinline__ void xcd_barrier_complete(unsigned* bar, unsigned x, unsigned& nloc, unsigned& nx) {
    const unsigned G = gridDim.x * gridDim.y * gridDim.z;
    unsigned sum, cnt, mine, sp = 0u;
    for (;;) {
        sum = 0u; cnt = 0u; mine = 0u;
#pragma unroll
        for (unsigned j = 0; j < 16; ++j) { const unsigned c = xb_ld(&bar[XB_XCNT(j)]); sum += c; cnt += (c > 0u) ? 1u : 0u; mine = (j == x) ? c : mine; }
        if (sum == G) break;
        __builtin_amdgcn_s_sleep(1);
        if ((++sp & 255u) == 0u) { if (xb_ld(&bar[XB_TMO])) break; if (sp > XB_SPIN_CAP) { atomicAdd(&bar[XB_TMO], 1u); break; } }
    }
    nloc = mine > 0u ? mine : 1u; nx = cnt > 0u ? cnt : 1u;
}

__device__ __forceinline__ void xcd_barrier(const XcdBarrier& b) {
    asm volatile("s_waitcnt vmcnt(0)" ::: "memory");
    __syncthreads();
    if (threadIdx.x == 0) {
        unsigned* bar = b.bar;
        __builtin_amdgcn_s_waitcnt(0);
        unsigned nloc = b.st[0], nx = b.st[1];
        if (nloc == 0u) { xcd_barrier_complete(bar, b.x, nloc, nx); b.st[0] = nloc; b.st[1] = nx; }
        const unsigned old = xb_add(&bar[XB_XSUB(b.x)], 1u);
        const unsigned gen = old / nloc;
        if (old + 1u == (gen + 1u) * nloc) {
            __builtin_amdgcn_fence(__ATOMIC_RELEASE, "agent");
            asm volatile("s_waitcnt vmcnt(0)" ::: "memory");
            const unsigned og = xb_add(&bar[XB_TOP], 1u);
            const unsigned tg = og / nx;
            if (og + 1u == (tg + 1u) * nx) xb_add(&bar[XB_TOPGEN], 1u);
            else XB_SPIN(xb_ld(&bar[XB_TOPGEN]) == tg, bar);
            __builtin_amdgcn_fence(__ATOMIC_ACQUIRE, "agent");
            xb_add(&bar[XB_XGEN(b.x)], 1u);
            asm volatile("s_waitcnt vmcnt(0)" ::: "memory");
        } else {
            XB_SPIN(xb_ld(&bar[XB_XGEN(b.x)]) == gen, bar);
            __builtin_amdgcn_fence(__ATOMIC_ACQUIRE, "agent");
            asm volatile("s_waitcnt vmcnt(0)" ::: "memory");
        }
    }
    __syncthreads();
}

__device__ __forceinline__ void sub_barrier_once(unsigned* word, unsigned n) {
    asm volatile("s_waitcnt vmcnt(0)" ::: "memory");
    __syncthreads();
    if (threadIdx.x == 0) {
        __builtin_amdgcn_fence(__ATOMIC_RELEASE, "agent");
        asm volatile("s_waitcnt vmcnt(0)" ::: "memory");
        (void)xb_add(word, 1u);
        unsigned sp = 0;
        while (xb_ld(word) < n) { __builtin_amdgcn_s_sleep(2); if (++sp > (1u << 22)) break; }
        __builtin_amdgcn_fence(__ATOMIC_ACQUIRE, "agent");
        asm volatile("s_waitcnt vmcnt(0)" ::: "memory");
    }
    __syncthreads();
}

__device__ __forceinline__ void p0_transpose_item(const float* W, const float* gvec, int K, int N, bf16* WT, int mode, LAS float* scr, int item, int lane) {
    const int nblk = N / 32, kb = item / nblk, nb = item % nblk, k0 = 64 * kb, n0 = 32 * nb;
#pragma unroll 8
    for (int i = 0; i < 32; ++i) { const int kk = 2 * i + (lane >> 5); const float g = gvec ? gvec[k0 + kk] : 1.0f; scr[kk * 33 + (lane & 31)] = W[(size_t)(k0 + kk) * N + n0 + (lane & 31)] * g; }
    asm volatile("s_waitcnt lgkmcnt(0)" ::: "memory");
    int d0 = n0;
    if (mode == 1 && n0 < 1280) { const int pn = n0 >> 8, w = n0 & 255, hh = w >> 6, half = (w >> 5) & 1; d0 = 256 * pn + 128 * half + 32 * hh; }
    const int c = lane & 7;
#pragma unroll
    for (int j = 0; j < 4; ++j) { const int n = (lane >> 3) + 8 * j; const LAS float* s = scr + (8 * c) * 33 + n;
        u32x4 o; o.x = pk2(s[0 * 33], s[1 * 33]); o.y = pk2(s[2 * 33], s[3 * 33]); o.z = pk2(s[4 * 33], s[5 * 33]); o.w = pk2(s[6 * 33], s[7 * 33]);
        *(u32x4*)(WT + (size_t)(d0 + n) * K + k0 + 8 * c) = o; }
    asm volatile("s_waitcnt lgkmcnt(0)" ::: "memory");
}

struct Args { const float* in[16]; float* out; unsigned char* ws; };

template <class PtrTab> __device__ __forceinline__ void convert_layer_weights(PtrTab in, unsigned char* ws, int L, LAS float* scr, int w0, int nw, int lane) {
    constexpr int I_RIN = 16 * 192, I_ROUT = 32 * 32, I_QKV = 16 * 48, I_WO = 16 * 32, I_UP = 16 * 128, I_DN = 64 * 32;
    const int l = L >> 1; const bool isret = !(L & 1);
    const int n_a = isret ? I_RIN : I_QKV, n_b = isret ? I_ROUT : I_WO, total = n_a + n_b + I_UP + I_DN;
    for (int it = w0; it < total; it += nw) {
        int r = it;
        if (r < n_a) { if (isret) p0_transpose_item(in[7] + (size_t)l * D * RN, in[5] + (size_t)L * D, D, RN, (bf16*)(ws + WS_RIN) + (size_t)l * RN * D, 0, scr, r, lane);
                       else p0_transpose_item(in[9] + (size_t)l * D * SN, in[5] + (size_t)L * D, D, SN, (bf16*)(ws + WS_QKV) + (size_t)l * SN * D, 1, scr, r, lane); continue; } r -= n_a;
        if (r < n_b) { if (isret) p0_transpose_item(in[8] + (size_t)l * RO * D, (const float*)nullptr, RO, D, (bf16*)(ws + WS_ROUT) + (size_t)l * D * RO, 0, scr, r, lane);
                       else p0_transpose_item(in[13] + (size_t)l * D * D, (const float*)nullptr, D, D, (bf16*)(ws + WS_WO) + (size_t)l * D * D, 0, scr, r, lane); continue; } r -= n_b;
        if (r < I_UP) { p0_transpose_item(in[14] + (size_t)L * D * FF, in[6] + (size_t)L * D, D, FF, (bf16*)(ws + WS_UP) + (size_t)L * FF * D, 0, scr, r, lane); continue; } r -= I_UP;
        p0_transpose_item(in[15] + (size_t)L * FF * D, (const float*)nullptr, FF, D, (bf16*)(ws + WS_DN) + (size_t)L * D * FF, 0, scr, r, lane);
    }
}

template <class PtrTab> __device__ __forceinline__ void copy_sample_caches(PtrTab in, float* out, int gt, int NGT) {
    {
        constexpr int PER = (WIN - DECT) * HKV * DH / 4;
        constexpr int TOT = 2 * DECB * PER;
        for (int i0 = gt; i0 < 2 * TOT; i0 += 4 * NGT) {
            f32x4 v[4]; float* dst[4];
#pragma unroll
            for (int u = 0; u < 4; ++u) {
                const int i = i0 + u * NGT < 2 * TOT ? i0 + u * NGT : i0;
                const int which = i >= TOT; const int k = which ? i - TOT : i; const int ab = k / PER, r = k - ab * PER;
                v[u] = __builtin_nontemporal_load((const f32x4*)(in[3 + which] + (size_t)ab * (WIN * HKV * DH) + DECT * HKV * DH + (size_t)r * 4));
                dst[u] = out + (which ? O_CVS : O_CKS) + (size_t)ab * (WIN * HKV * DH) + (size_t)r * 4;
            }
#pragma unroll
            for (int u = 0; u < 4; ++u) __builtin_nontemporal_store(v[u], (f32x4*)dst[u]);
        }
    }
}

__device__ __forceinline__ void p0_prologue(const Args& a, LAS unsigned char* lds, int bid, int G, int tid) {
    const int lane = tid & 63, wave = tid >> 6;
    LAS float* scr = (LAS float*)(lds + wave * 16384);
    const int gw = bid * 8 + wave, NGW = G * 8;
    unsigned char* ws = a.ws;
    convert_layer_weights(a.in, ws, 0, scr, gw, NGW, lane);
    bf16* XB = (bf16*)(ws + WS_XB); float* SSQ = (float*)(ws + WS_SSQ);
    for (int m0 = gw; m0 < M; m0 += 2 * NGW) {
        f32x4 v[2][4]; int mm[2];
#pragma unroll
        for (int u = 0; u < 2; ++u) {
            mm[u] = m0 + u * NGW < M ? m0 + u * NGW : m0;
            const float* src = mm[u] < MP ? a.in[0] + (size_t)mm[u] * D : a.in[1] + (size_t)(mm[u] - MP) * D;
#pragma unroll
            for (int j = 0; j < 4; ++j) v[u][j] = __builtin_nontemporal_load((const f32x4*)src + lane + 64 * j);
        }
#pragma unroll
        for (int u = 0; u < 2; ++u) {
            u32x2* brow = (u32x2*)(XB + (size_t)mm[u] * D) + lane;
            float s = 0.f;
#pragma unroll
            for (int j = 0; j < 4; ++j) { s += dot4(v[u][j]); u32x2 w; w.x = pk2(v[u][j].x, v[u][j].y); w.y = pk2(v[u][j].z, v[u][j].w); brow[64 * j] = w; }
            s = wave_sum(s);
            if (lane < 16) SSQ[(size_t)mm[u] * 16 + lane] = lane == 0 ? s : 0.f;
        }
    }
    const int gt = bid * NT + tid, NGT = G * NT;
    float* TABR = (float*)(ws + WS_TABR); float* TABS = (float*)(ws + WS_TABS);
    for (int i = gt; i < NPOS * 160; i += NGT) {
        int p, f, half; float* dst;
        if (i < NPOS * 128) { p = i >> 7; f = i & 127; half = 128; dst = TABR + (size_t)i * 2; }
        else { const int k = i - NPOS * 128; p = k >> 5; f = k & 31; half = 32; dst = TABS + (size_t)k * 2; }
        const int pos = p < SEQ ? p : PAST + (p - SEQ);
        const float inv = exp2f(-((float)f / (float)half) * 13.287712379549449f);
        const double ang = (double)pos * (double)inv;
        const double kq = __builtin_rint(ang * 0.15915494309189535);
        const float rr = (float)(ang - kq * 6.283185307179586);
        dst[0] = cosf(rr); dst[1] = sinf(rr);
    }
}

__device__ __forceinline__ void attn16(LAS const unsigned char* Ks, LAS const unsigned char* Vs, int tile0, int kpos0, const bf16x8 (&qf)[2], int qpos, float sink, f32x4 (&o)[4], float& inv, int lane) {
    const int c = lane & 15, g = lane >> 4, q4 = c >> 2, p4 = c & 3;
    f32x4 s[10];
    float mx = sink;
    bf16x8 Kf[10][2];
#pragma unroll
    for (int tt = 0; tt < 10; ++tt)
#pragma unroll
        for (int ks = 0; ks < 2; ++ks) Kf[tt][ks] = *(LAS const bf16x8*)(Ks + ((16 * (tile0 + tt) + c) * 72 + 32 * ks + 8 * g) * 2);
    __builtin_amdgcn_sched_barrier(0);
#pragma unroll
    for (int tt = 0; tt < 10; ++tt) {
        f32x4 acc = {0.f, 0.f, 0.f, 0.f};
#pragma unroll
        for (int ks = 0; ks < 2; ++ks) acc = MFMA16(Kf[tt][ks], qf[ks], acc);
#pragma unroll
        for (int r = 0; r < 4; ++r) {
            const int kpos = kpos0 + 16 * (tile0 + tt) + 4 * g + r, dd = qpos - kpos;
            const bool ok = dd >= 0 && dd < WIN && kpos >= 0;
            acc[r] = ok ? acc[r] * 0.125f : -1e30f;
            mx = fmaxf(mx, acc[r]);
        }
        s[tt] = acc;
    }
    mx = fmaxf(mx, __shfl_xor(mx, 16)); mx = fmaxf(mx, __shfl_xor(mx, 32));
    float sum = 0.f;
#pragma unroll
    for (int tt = 0; tt < 10; ++tt)
#pragma unroll
        for (int r = 0; r < 4; ++r) { const float p = s[tt][r] > -1e29f ? __expf(s[tt][r] - mx) : 0.f; s[tt][r] = p; sum += p; }
    sum += __shfl_xor(sum, 16); sum += __shfl_xor(sum, 32);
    inv = 1.0f / (sum + __expf(sink - mx));
#pragma unroll
    for (int mt = 0; mt < 4; ++mt) o[mt] = (f32x4){0.f, 0.f, 0.f, 0.f};
    {
        s16x4 vl[5][4], vh[5][4];
#pragma unroll
        for (int tp = 0; tp < 5; ++tp)
#pragma unroll
            for (int mt = 0; mt < 4; ++mt) {
                vl[tp][mt] = vtr(Vs + ((16 * (tile0 + 2 * tp) + 4 * g + q4) * 72 + 16 * mt + 4 * p4) * 2);
                vh[tp][mt] = vtr(Vs + ((16 * (tile0 + 2 * tp + 1) + 4 * g + q4) * 72 + 16 * mt + 4 * p4) * 2);
            }
        __builtin_amdgcn_sched_barrier(0);
#pragma unroll
        for (int tp = 0; tp < 5; ++tp) {
            const bf16x8 pf = packp(s[2 * tp], s[2 * tp + 1]);
#pragma unroll
            for (int mt = 0; mt < 4; ++mt) o[mt] = MFMA16(cat8(vl[tp][mt], vh[tp][mt]), pf, o[mt]);
        }
    }
}

__device__ __forceinline__ void attn_prompt_item(LAS unsigned char* lds, const bf16* P, bf16* OG, const float* sinks, int item, int tid) {
    asm volatile("" : "+v"(tid));
    const int lane = tid & 63, w = __builtin_amdgcn_readfirstlane(tid >> 6), c = lane & 15, g = lane >> 4;
    const int b = item >> 7, blk = (item >> 2) & 31, kvh = item & 3;
    LAS unsigned char* Ks = lds; LAS unsigned char* Vs = lds + 36864;
    const int hq = kvh * 4 + (w >> 1);
    u32x4 kv[4], vv[4]; bf16x8 qa[4][2];
#pragma unroll
    for (int it = 0; it < 4; ++it) {
        const int idx = tid + NT * it, kk = idx >> 3, ch = idx & 7;
        kv[it] = (u32x4){0u, 0u, 0u, 0u}; vv[it] = (u32x4){0u, 0u, 0u, 0u};
        if (blk > 0 || kk >= 128) { const bf16* src = P + (size_t)(b * SEQ + (blk - 1) * 128 + kk) * SN + kvh * 64 + ch * 8; kv[it] = *(const u32x4*)(src + 1024); vv[it] = *(const u32x4*)(src + 1280); }
    }
#pragma unroll
    for (int sb = 0; sb < 4; ++sb)
#pragma unroll
        for (int ks = 0; ks < 2; ++ks) qa[sb][ks] = *(const bf16x8*)(P + (size_t)(b * SEQ + blk * 128 + 64 * (w & 1) + 16 * sb + c) * SN + hq * 64 + 32 * ks + 8 * g);
#pragma unroll
    for (int it = 0; it < 4; ++it) {
        const int idx = tid + NT * it, kk = idx >> 3, ch = idx & 7;
        *(LAS u32x4*)(Ks + (kk * 72 + ch * 8) * 2) = kv[it]; *(LAS u32x4*)(Vs + (kk * 72 + ch * 8) * 2) = vv[it];
    }
    __syncthreads();
    const float sink = sinks[hq];
#pragma unroll
    for (int sb = 0; sb < 4; ++sb) {
        const int i0 = 64 * (w & 1) + 16 * sb, qrow = b * SEQ + blk * 128 + i0 + c;
        const int tile0 = (i0 >> 4) < 6 ? (i0 >> 4) : 6;
        f32x4 o[4]; float inv;
        attn16(Ks, Vs, tile0, (blk - 1) * 128, qa[sb], blk * 128 + i0 + c, sink, o, inv, lane);
#pragma unroll
        for (int mt = 0; mt < 4; ++mt) { u32x2 wv; wv.x = pk2(o[mt].x * inv, o[mt].y * inv); wv.y = pk2(o[mt].z * inv, o[mt].w * inv); *(u32x2*)(OG + (size_t)qrow * D + hq * 64 + 16 * mt + 4 * g) = wv; }
    }
    __syncthreads();
}

__device__ __forceinline__ void attn_sample_load(LAS unsigned char* wl, const bf16* P, const float* ck, const float* cv, int item, int qw, int lane) {
    asm volatile("" : "+v"(lane));
    const int b = item >> 2, kvh = item & 3;
    LAS unsigned char* Ks = wl; LAS unsigned char* Vs = wl + 23040;
    f32x4 kx[8], vx[8];
#pragma unroll
    for (int it = 0; it < 8; ++it) {
        const int idx = lane + 64 * it, l = 32 * qw + (idx >> 4), c4 = idx & 15;
        const size_t off = (((size_t)b * WIN + l) * HKV + kvh) * DH + c4 * 4;
        kx[it] = __builtin_nontemporal_load((const f32x4*)(ck + off)); vx[it] = __builtin_nontemporal_load((const f32x4*)(cv + off));
    }
#pragma unroll
    for (int it = 0; it < 8; ++it) {
        const int idx = lane + 64 * it, l = 32 * qw + (idx >> 4), c4 = idx & 15;
        u32x2 kw, vw; kw.x = pk2(kx[it].x, kx[it].y); kw.y = pk2(kx[it].z, kx[it].w); vw.x = pk2(vx[it].x, vx[it].y); vw.y = pk2(vx[it].z, vx[it].w);
        *(LAS u32x2*)(Ks + (l * 72 + c4 * 4) * 2) = kw; *(LAS u32x2*)(Vs + (l * 72 + c4 * 4) * 2) = vw;
    }
    {
        const int idx = lane + 64 * qw, rr = idx >> 3, ch = idx & 7;
        u32x4 kv = {0u, 0u, 0u, 0u}, vv = {0u, 0u, 0u, 0u};
        if (rr < DECT) { const bf16* src = P + (size_t)(MP + b * DECT + rr) * SN + kvh * 64 + ch * 8; kv = *(const u32x4*)(src + 1024); vv = *(const u32x4*)(src + 1280); }
        *(LAS u32x4*)(Ks + ((128 + rr) * 72 + ch * 8) * 2) = kv; *(LAS u32x4*)(Vs + ((128 + rr) * 72 + ch * 8) * 2) = vv;
    }
}
__device__ __forceinline__ void attn_sample_compute(LAS unsigned char* wl, const bf16* P, bf16* OG, const float* sinks, int item, int lane) {
    asm volatile("" : "+v"(lane));
    const int c = lane & 15, g = lane >> 4;
    const int b = item >> 2, kvh = item & 3;
    LAS unsigned char* Ks = wl; LAS unsigned char* Vs = wl + 23040;
    const int t = c >> 2, hq = kvh * 4 + (c & 3), qrow = MP + b * DECT + t;
    bf16x8 qf[2];
#pragma unroll
    for (int ks = 0; ks < 2; ++ks) qf[ks] = *(const bf16x8*)(P + (size_t)qrow * SN + hq * 64 + 32 * ks + 8 * g);
    f32x4 o[4]; float inv;
    attn16(Ks, Vs, 0, PAST - WIN, qf, PAST + t, sinks[hq], o, inv, lane);
#pragma unroll
    for (int mt = 0; mt < 4; ++mt) { u32x2 wv; wv.x = pk2(o[mt].x * inv, o[mt].y * inv); wv.y = pk2(o[mt].z * inv, o[mt].w * inv); *(u32x2*)(OG + (size_t)qrow * D + hq * 64 + 16 * mt + 4 * g) = wv; }
}

#define SB() __builtin_amdgcn_sched_barrier(0)
#define LBAR() do { asm volatile("s_waitcnt lgkmcnt(0)" ::: "memory"); __builtin_amdgcn_s_barrier(); asm volatile("" ::: "memory"); } while (0)
__device__ __forceinline__ void ret_prompt_item(LAS unsigned char* lds, const bf16* P, bf16* OG, float* GN, float* state_out, int item, int tid) {
    asm volatile("" : "+v"(tid));
    const int lane = tid & 63, w = __builtin_amdgcn_readfirstlane(tid >> 6), c = lane & 15, g = lane >> 4, q4 = c >> 2, p4 = c & 3;
    const int bh = 2 * (item & 7) + ((item >> 3) >> 3), es = (item >> 3) & 7, b = bh >> 2, h = bh & 3;
    const float lg = uni(log2f(1.0f - exp2f(-5.0f - (float)h)));
    LAS unsigned char* Ks = lds; LAS unsigned char* Vs = lds + 69632; LAS unsigned char* Vd = Vs + 18432; LAS unsigned char* Ss = Vd + 18432;
    for (int i = tid; i < 34816 / 16; i += NT) ((LAS u32x4*)Ss)[i] = (u32x4){0u, 0u, 0u, 0u};
    f32x4 Sacc[2][4];
#pragma unroll
    for (int md = 0; md < 2; ++md)
#pragma unroll
        for (int ne = 0; ne < 4; ++ne) Sacc[md][ne] = (f32x4){0.f, 0.f, 0.f, 0.f};
    const float cdec = uni(exp2f(128.0f * lg));
    const float gi0 = exp2f((float)(16 * w + c) * lg), g16i = uni(exp2f(-16.0f * lg)), gam1 = uni(exp2f(lg));
    const float gj0 = exp2f(-(float)(4 * g) * lg);
    float gru[4], tfac[4];
#pragma unroll
    for (int r = 0; r < 4; ++r) { gru[r] = uni(exp2f(-(float)r * lg)); tfac[r] = uni(exp2f(-32.0f * (float)r * lg)); }
    const bf16* Pk = P + (size_t)(b * SEQ) * RN + 1024 + h * 256; const bf16* Pv = P + (size_t)(b * SEQ) * RN + 2048 + h * 512 + es * 64; const bf16* Pq = P + (size_t)(b * SEQ) * RN + h * 256;
#define kp (Pk + ((unsigned)(tl_ >> 5) * RN + (tl_ & 31) * 8))
#define vp (Pv + ((unsigned)(tl_ >> 3) * RN + (tl_ & 7) * 8))
#define qp (Pq + ((unsigned)(tl_ & 0x1cf) * 0 + (unsigned)(16 * (tl_ >> 6) + (tl_ & 15)) * RN + 8 * ((tl_ >> 4) & 3)))
    int tl_ = tid;
    const float g64i = uni(exp2f(-64.0f * lg));
    u32x4 kpre[8], vpre[2]; bf16x8 qf[8];
#pragma unroll
    for (int it = 0; it < 8; ++it) kpre[it] = *(const u32x4*)(kp + (size_t)(16 * it) * RN);
#pragma unroll
    for (int it = 0; it < 2; ++it) vpre[it] = *(const u32x4*)(vp + (size_t)(64 * it) * RN);
#pragma unroll
    for (int ks = 0; ks < 8; ++ks) qf[ks] = *(const bf16x8*)(qp + 32 * ks);
#pragma unroll 1
    for (int n = 0; n < SEQ / 128; ++n) {
        LBAR();
        float gi = gi0; int ib = 16 * w + c; tl_ = tid; asm volatile("" : "+v"(gi), "+v"(ib), "+v"(tl_));
#pragma unroll
        for (int it = 0; it < 8; ++it) *(LAS u32x4*)(Ks + (((tid >> 5) + 16 * it) * 272 + (tid & 31) * 8) * 2) = kpre[it];
#pragma unroll
        for (int it = 0; it < 2; ++it) { const u32x4 v = vpre[it]; const int j = (tid >> 3) + 64 * it; const float vf0 = exp2f((float)(127 - (tl_ >> 3)) * lg); const float f = it ? vf0 * g64i : vf0;
            *(LAS u32x4*)(Vs + (j * 72 + (tid & 7) * 8) * 2) = v;
            u32x4 d; d.x = pk2(bflo(v.x) * f, bfhi(v.x) * f); d.y = pk2(bflo(v.y) * f, bfhi(v.y) * f); d.z = pk2(bflo(v.z) * f, bfhi(v.z) * f); d.w = pk2(bflo(v.w) * f, bfhi(v.w) * f);
            *(LAS u32x4*)(Vd + (j * 72 + (tid & 7) * 8) * 2) = d; }
        const int qrow = b * SEQ + n * 128 + 16 * w + c;
        const size_t adv = (size_t)(n + 1 < SEQ / 128 ? n + 1 : n) * 128 * RN;
        {
#pragma unroll
            for (int it = 0; it < 8; ++it) kpre[it] = *(const u32x4*)(kp + adv + (size_t)(16 * it) * RN);
#pragma unroll
            for (int it = 0; it < 2; ++it) vpre[it] = *(const u32x4*)(vp + adv + (size_t)(64 * it) * RN);
        }
        LBAR();
        f32x4 oT[4];
#pragma unroll
        for (int mt = 0; mt < 4; ++mt) {
            f32x4 acc = {0.f, 0.f, 0.f, 0.f};
#pragma unroll
            for (int kh = 0; kh < 2; ++kh) {
                bf16x8 Ab[4];
#pragma unroll
                for (int ks = 0; ks < 4; ++ks) Ab[ks] = *(LAS const bf16x8*)(Ss + ((16 * mt + c) * 272 + 32 * (4 * kh + ks) + 8 * g) * 2);
                SB();
#pragma unroll
                for (int ks = 0; ks < 4; ++ks) acc = MFMA16(Ab[ks], qf[4 * kh + ks], acc);
                SB();
            }
            oT[mt] = acc * (gi * gam1);
        }
#pragma unroll
        for (int tp = 0; tp < 4; ++tp) {
            if (2 * tp <= w) {
                bf16x8 A0[4], A1[4]; s16x4 vlo[4], vhi[4];
                f32x4 sA = {0.f, 0.f, 0.f, 0.f}, sB = {0.f, 0.f, 0.f, 0.f};
#pragma unroll
                for (int kh = 0; kh < 2; ++kh) {
#pragma unroll
                    for (int ks = 0; ks < 4; ++ks) {
                        A0[ks] = *(LAS const bf16x8*)(Ks + ((32 * tp + c) * 272 + 32 * (4 * kh + ks) + 8 * g) * 2);
                        A1[ks] = *(LAS const bf16x8*)(Ks + ((32 * tp + 16 + c) * 272 + 32 * (4 * kh + ks) + 8 * g) * 2);
                    }
                    SB();
#pragma unroll
                    for (int ks = 0; ks < 4; ++ks) { sA = MFMA16(A0[ks], qf[4 * kh + ks], sA); sB = MFMA16(A1[ks], qf[4 * kh + ks], sB); }
                    SB();
                }
#pragma unroll
                for (int mt = 0; mt < 4; ++mt) {
                    vlo[mt] = vtr(Vs + ((32 * tp + 4 * g + q4) * 72 + 16 * mt + 4 * p4) * 2);
                    vhi[mt] = vtr(Vs + ((32 * tp + 16 + 4 * g + q4) * 72 + 16 * mt + 4 * p4) * 2);
                }
                const float gt = gi * tfac[tp] * gj0;
#pragma unroll
                for (int r = 0; r < 4; ++r) {
                    const int dj = ib - (32 * tp + 4 * g + r);
                    const float fa = gt * gru[r];
                    sA[r] = dj >= 0 ? sA[r] * fa : 0.f;
                    sB[r] = dj >= 16 ? sB[r] * (fa * g16i) : 0.f;
                }
                const bf16x8 pf = packp(sA, sB);
#pragma unroll
                for (int mt = 0; mt < 4; ++mt) oT[mt] = MFMA16(cat8(vlo[mt], vhi[mt]), pf, oT[mt]);
                SB();
            }
        }
        {
            float ss = 0.f;
#pragma unroll
            for (int mt = 0; mt < 4; ++mt) { ss += dot4(oT[mt]); u32x2 wv; wv.x = pk2(oT[mt].x, oT[mt].y); wv.y = pk2(oT[mt].z, oT[mt].w); *(u32x2*)(OG + (size_t)qrow * RO + h * 512 + es * 64 + 16 * mt + 4 * g) = wv; }
            ss += __shfl_xor(ss, 16); ss += __shfl_xor(ss, 32);
            if (g == 0) GN[(size_t)qrow * 32 + h * 8 + es] = ss;
        }
        tl_ = tid; asm volatile("" : "+v"(tl_));
        {
#pragma unroll
            for (int ks = 0; ks < 8; ++ks) qf[ks] = *(const bf16x8*)(qp + adv + 32 * ks);
        }
#pragma unroll
        for (int md = 0; md < 2; ++md)
#pragma unroll
            for (int ne = 0; ne < 4; ++ne) Sacc[md][ne] = Sacc[md][ne] * cdec;
#pragma unroll
        for (int kj = 0; kj < 4; ++kj) {
            s16x4 tl[6], th[6];
#pragma unroll
            for (int md = 0; md < 2; ++md) {
                tl[md] = vtr(Ks + ((32 * kj + 8 * g + q4) * 272 + 32 * w + 16 * md + 4 * p4) * 2); th[md] = vtr(Ks + ((32 * kj + 8 * g + 4 + q4) * 272 + 32 * w + 16 * md + 4 * p4) * 2); }
#pragma unroll
            for (int ne = 0; ne < 4; ++ne) {
                tl[2 + ne] = vtr(Vd + ((32 * kj + 8 * g + q4) * 72 + 16 * ne + 4 * p4) * 2); th[2 + ne] = vtr(Vd + ((32 * kj + 8 * g + 4 + q4) * 72 + 16 * ne + 4 * p4) * 2); }
            SB();
#pragma unroll
            for (int md = 0; md < 2; ++md)
#pragma unroll
                for (int ne = 0; ne < 4; ++ne) Sacc[md][ne] = MFMA16(cat8(tl[md], th[md]), cat8(tl[2 + ne], th[2 + ne]), Sacc[md][ne]);
            SB();
        }
        LBAR();
#pragma unroll
        for (int md = 0; md < 2; ++md)
#pragma unroll
            for (int ne = 0; ne < 4; ++ne) { u32x2 wv; wv.x = pk2(Sacc[md][ne].x, Sacc[md][ne].y); wv.y = pk2(Sacc[md][ne].z, Sacc[md][ne].w);
                *(LAS u32x2*)(Ss + ((16 * ne + c) * 272 + 32 * w + 16 * md + 4 * g) * 2) = wv; }
    }
#pragma unroll
    for (int md = 0; md < 2; ++md)
#pragma unroll
        for (int ne = 0; ne < 4; ++ne)
#pragma unroll
            for (int r = 0; r < 4; ++r) state_out[((size_t)(b * RH + h) * RDK + 32 * w + 16 * md + 4 * g + r) * RDV + es * 64 + 16 * ne + c] = Sacc[md][ne][r];
    __syncthreads();
}
#undef kp
#undef vp
#undef qp

__device__ __forceinline__ void ret_sample_item(LAS unsigned char* lds, const bf16* P, bf16* OG, const float* S0, float* S1, int item, int tid) {
    asm volatile("" : "+v"(tid));
    const int lane = tid & 63, w = tid >> 6;
    const int b = item >> 2, h = item & 3, R0 = MP + b * DECT;
    const float lg = log2f(1.0f - exp2f(-5.0f - (float)h));
    LAS float* qs = (LAS float*)lds; LAS float* ks = qs + 1024; LAS float* vs = ks + 1024; LAS float* sc = vs + 2048; LAS float* red = sc + 64; LAS float* nrm = red + 8192;
#pragma unroll
    for (int it = 0; it < 2; ++it) { const int e = tid + NT * it, i = e >> 8, d = e & 255;
        qs[e] = bf2f(P[(size_t)(R0 + i) * RN + h * 256 + d]); ks[e] = bf2f(P[(size_t)(R0 + i) * RN + 1024 + h * 256 + d]) * exp2f((float)(3 - i) * lg); }
#pragma unroll
    for (int i = 0; i < 4; ++i) vs[i * 512 + tid] = bf2f(P[(size_t)(R0 + i) * RN + 2048 + h * 512 + tid]);
    __syncthreads();
#pragma unroll
    for (int k = 0; k < 2; ++k) { const int en = 2 * w + k, i = en >> 2, j = en & 3;
        float pt = 0.f;
#pragma unroll
        for (int dd = 0; dd < 4; ++dd) pt += qs[i * 256 + lane + 64 * dd] * ks[j * 256 + lane + 64 * dd];
        pt = wave_sum(pt);
        if (lane == 0) sc[en] = j <= i ? pt * exp2f((float)(i - 3) * lg) : 0.f; }
    const int e4 = (tid & 127) * 4, dq = tid >> 7;
    f32x4 v[4], cacc[4];
#pragma unroll
    for (int j = 0; j < 4; ++j) { v[j] = *(LAS const f32x4*)(vs + j * 512 + e4); cacc[j] = (f32x4){0.f, 0.f, 0.f, 0.f}; }
    const float c4 = exp2f(4.0f * lg);
    const size_t sbase = ((size_t)(b * RH + h) * RDK + dq * 64) * RDV + e4;
    const float* sp = S0 + sbase; float* dp = S1 + sbase;
    {
        f32x4 sa[8], sb[8];
#define RS_LOAD(dst, r0) do { _Pragma("unroll") for (int u = 0; u < 8; ++u) dst[u] = __builtin_nontemporal_load((const f32x4*)(sp + (size_t)((r0) + u) * RDV)); } while (0)
#define RS_USE(src, r0) do { _Pragma("unroll") for (int u = 0; u < 8; ++u) { const int d = dq * 64 + (r0) + u; const f32x4 sv = src[u]; f32x4 sf = sv * c4; \
            _Pragma("unroll") for (int j = 0; j < 4; ++j) { cacc[j] += sv * qs[j * 256 + d]; sf += v[j] * ks[j * 256 + d]; } \
            __builtin_nontemporal_store(sf, (f32x4*)(dp + (size_t)((r0) + u) * RDV)); } } while (0)
        RS_LOAD(sa, 0);
#pragma unroll
        for (int it = 0; it < 4; ++it) {
            RS_LOAD(sb, 16 * it + 8);
            SB();
            RS_USE(sa, 16 * it);
            SB();
            RS_LOAD(sa, it < 3 ? 16 * it + 16 : 48);
            SB();
            RS_USE(sb, 16 * it + 8);
            SB();
        }
#undef RS_LOAD
#undef RS_USE
    }
#pragma unroll
    for (int i = 0; i < 4; ++i) *(LAS f32x4*)(red + (dq * 4 + i) * 512 + e4) = cacc[i];
    __syncthreads();
    float o[4];
#pragma unroll
    for (int i = 0; i < 4; ++i) {
        float cr = (red[(0 * 4 + i) * 512 + tid] + red[(1 * 4 + i) * 512 + tid]) + (red[(2 * 4 + i) * 512 + tid] + red[(3 * 4 + i) * 512 + tid]);
        cr *= exp2f((float)(i + 1) * lg);
#pragma unroll
        for (int j = 0; j < 4; ++j) cr += sc[i * 4 + j] * vs[j * 512 + tid];
        o[i] = cr;
        const float s2 = wave_sum(cr * cr);
        if (lane == 0) nrm[w * 4 + i] = s2;
    }
    __syncthreads();
#pragma unroll
    for (int i = 0; i < 4; ++i) {
        float tot = 0.f;
#pragma unroll
        for (int ww = 0; ww < 8; ++ww) tot += nrm[ww * 4 + i];
        const float rs = rsqrtf(tot * (1.0f / 512.0f) + EPS);
        const float sg = bf2f(P[(size_t)(R0 + i) * RN + 4096 + h * 512 + tid]);
        OG[(size_t)(R0 + i) * RO + h * 512 + tid] = (bf16)(pk2(o[i] * rs * sg, 0.f) & 0xffffu);
    }
    __syncthreads();
}

__device__ __forceinline__ void ret_normalize(const bf16* P, bf16* OG, const float* GN, int bid, int G, int tid) {
    asm volatile("" : "+v"(tid));
    const int lane = tid & 63, gw = bid * 8 + (tid >> 6), NGW = G * 8;
    for (int idx0 = gw * 4; idx0 < MP * RH; idx0 += NGW * 4) {
        const int row = idx0 >> 2;
        u32x4 o[4], sg[4]; f32x4 ga[4], gb[4];
#pragma unroll
        for (int h = 0; h < 4; ++h) {
            const f32x4* gp = (const f32x4*)(GN + (size_t)row * 32 + h * 8); ga[h] = gp[0]; gb[h] = gp[1];
            o[h] = __builtin_nontemporal_load((const u32x4*)(OG + (size_t)row * RO + h * 512) + lane); sg[h] = __builtin_nontemporal_load((const u32x4*)(P + (size_t)row * RN + 4096 + h * 512) + lane);
        }
#pragma unroll
        for (int h = 0; h < 4; ++h) {
            const float rs = rsqrtf((((ga[h].x + ga[h].y) + (ga[h].z + ga[h].w)) + ((gb[h].x + gb[h].y) + (gb[h].z + gb[h].w))) * (1.0f / 512.0f) + EPS);
            u32x4 r;
            r.x = pk2(bflo(o[h].x) * rs * bflo(sg[h].x), bfhi(o[h].x) * rs * bfhi(sg[h].x)); r.y = pk2(bflo(o[h].y) * rs * bflo(sg[h].y), bfhi(o[h].y) * rs * bfhi(sg[h].y));
            r.z = pk2(bflo(o[h].z) * rs * bflo(sg[h].z), bfhi(o[h].z) * rs * bfhi(sg[h].z)); r.w = pk2(bflo(o[h].w) * rs * bflo(sg[h].w), bfhi(o[h].w) * rs * bfhi(sg[h].w));
            *((u32x4*)(OG + (size_t)row * RO + h * 512) + lane) = r;
        }
    }
}

__device__ __forceinline__ void mini_res_tile(LAS unsigned char* lds, const bf16* A, const bf16* Bt, int K, const float* Xin, float* X, bf16* XB, float* SSQ, int tile, int tid) {
    asm volatile("" : "+v"(tid));
    const int lane = tid & 63, w = __builtin_amdgcn_readfirstlane(tid >> 6), c = lane & 15, g = lane >> 4;
    const int rb = tile >> 4, cb = tile & 15, kw = K >> 3, k0 = w * kw;
    f32x4 acc[2][4];
#pragma unroll
    for (int m = 0; m < 2; ++m)
#pragma unroll
        for (int n = 0; n < 4; ++n) acc[m][n] = (f32x4){0.f, 0.f, 0.f, 0.f};
    const bf16* ap = A + (size_t)(MP + 32 * rb + c) * K + k0 + 8 * g;
    const bf16* bp = Bt + (size_t)(64 * cb + c) * K + k0 + 8 * g;
#pragma unroll 8
    for (int ks = 0; ks < kw; ks += 32) {
        bf16x8 a[2], b[4];
#pragma unroll
        for (int m = 0; m < 2; ++m) a[m] = *(const bf16x8*)(ap + (size_t)(16 * m) * K + ks);
#pragma unroll
        for (int n = 0; n < 4; ++n) b[n] = *(const bf16x8*)(bp + (size_t)(16 * n) * K + ks);
#pragma unroll
        for (int m = 0; m < 2; ++m)
#pragma unroll
            for (int n = 0; n < 4; ++n) acc[m][n] = MFMA16(a[m], b[n], acc[m][n]);
    }
    LAS float* red = (LAS float*)lds;
#pragma unroll
    for (int m = 0; m < 2; ++m)
#pragma unroll
        for (int n = 0; n < 4; ++n)
#pragma unroll
            for (int r = 0; r < 4; ++r) red[(w * 32 + 16 * m + 4 * g + r) * 68 + 16 * n + c] = acc[m][n][r];
    __syncthreads();
    const int row = tid >> 4, cq = tid & 15;
    f32x4 v = {0.f, 0.f, 0.f, 0.f};
#pragma unroll
    for (int ww = 0; ww < 8; ++ww) v += *(LAS const f32x4*)(red + (ww * 32 + row) * 68 + 4 * cq);
    const int grow = MP + 32 * rb + row, col = 64 * cb + 4 * cq;
    float* xp = X + (size_t)grow * D + col;
    const f32x4 x = *(const f32x4*)(Xin + (size_t)grow * D + col) + v;
    *(f32x4*)xp = x;
    u32x2 wv; wv.x = pk2(x.x, x.y); wv.y = pk2(x.z, x.w); *(u32x2*)(XB + (size_t)grow * D + col) = wv;
    float ss = dot4(x);
    ss += __shfl_xor(ss, 1); ss += __shfl_xor(ss, 2); ss += __shfl_xor(ss, 4); ss += __shfl_xor(ss, 8);
    if (cq == 0) SSQ[(size_t)grow * 16 + cb] = ss;
    __syncthreads();
}

#define KAS __attribute__((address_space(4)))
#define BAR_LDS_OFF (LDS_BYTES - 64)
#define GSYNC_CG() do { __threadfence(); grid.sync(); __threadfence(); } while (0)
#define GSYNC() do { XcdBarrier xb_; xb_.bar = (unsigned*)((const KAS Args*)__builtin_amdgcn_kernarg_segment_ptr())->ws; xb_.x = xb_xcc_id(); xb_.st = (volatile LAS unsigned*)(lds + BAR_LDS_OFF); xcd_barrier(xb_); } while (0)
#define PHASE_PTRS() const KAS Args* ap = (const KAS Args*)__builtin_amdgcn_kernarg_segment_ptr(); asm volatile("" : "+s"(ap)); unsigned char* ws = ap->ws; float* X = ap->out; \
    const int tid = threadIdx.x, bid = blockIdx.x, G = gridDim.x; (void)tid; (void)bid; (void)G; \
    bf16* XB = (bf16*)(ws + WS_XB); float* SSQ = (float*)(ws + WS_SSQ); bf16* PROJ = (bf16*)(ws + WS_PROJ); bf16* OG = (bf16*)(ws + WS_OG); bf16* ACT = (bf16*)(ws + WS_ACT); \
    (void)XB; (void)SSQ; (void)PROJ; (void)OG; (void)ACT; (void)X
template <int L> __device__ __forceinline__ void run_layer(cg::grid_group& grid, LAS unsigned char* lds) {
    constexpr bool isret = !(L & 1); constexpr int li = L >> 1;
#ifndef SKIP_G1
#ifndef SKIP_G1R
        if constexpr (isret) {
            PHASE_PTRS();
            const int mrows = G >= 256 ? MP : M;
            pg8::Gemm g{XB, (const bf16*)(ws + WS_RIN) + (size_t)li * RN * D, mrows, RN, D}; pg8::StaticOrder S; S.init(mrows, RN, G, bid);
            EpiRetIn E{PROJ, SSQ, (const float*)(ws + WS_TABR), 0};
            pg8::gemm_phase<EpiRetIn, pg8::StaticOrder, true, true>(lds, g, S, E);
        }
#endif
#ifndef SKIP_G1S
        if constexpr (!isret) {
            PHASE_PTRS();
            pg8::Gemm g{XB, (const bf16*)(ws + WS_QKV) + (size_t)li * SN * D, M, SN, D}; pg8::StaticOrder S; S.init(M, SN, G, bid);
            EpiSwaQkv E{PROJ, SSQ, (const float*)(ws + WS_TABS), ap->in[10] + li * DH, ap->in[11] + li * DH, X + O_CKP + li * CP_L, X + O_CVP + li * CP_L, X + O_CKS + li * CS_L, X + O_CVS + li * CS_L};
            pg8::gemm_phase<EpiSwaQkv, pg8::StaticOrder, true, true>(lds, g, S, E);
        }
#endif
#endif
        GSYNC();
        if constexpr (isret) {
            for (int rep = 0; rep < REP_RET; ++rep) {
            PHASE_PTRS();
            float* GN = (float*)(ws + WS_GN);
            const int npb = G >= 256 ? 128 : G;
#ifndef SKIP_RETP
            if (bid < npb) for (int it = bid; it < NB * RH * 8; it += npb) ret_prompt_item(lds, PROJ, OG, GN, X + O_SRP + li * SRP_L, it, tid);
#endif
#ifndef SKIP_RETS
            if (G >= 256 && bid >= 128) {
                pg8::Gemm g{XB + (size_t)MP * D, (const bf16*)(ws + WS_RIN) + (size_t)li * RN * D, MS, RN, D}; pg8::StaticOrder S; S.init(MS, RN, G - 128, bid - 128);
                EpiRetIn E{PROJ, SSQ, (const float*)(ws + WS_TABR), MP};
                pg8::gemm_phase<EpiRetIn, pg8::StaticOrder, true, true>(lds, g, S, E);
                sub_barrier_once((unsigned*)(ws + 16384) + 64 * li, (unsigned)(G - 128));
            }
            if (G >= 256) { if (bid >= 128) for (int it = bid - 128; it < DECB * RH; it += G - 128) ret_sample_item(lds, PROJ, OG, ap->in[2] + li * SRS_L, X + O_SRS + li * SRS_L, it, tid); }
            else for (int it = bid; it < DECB * RH; it += G) ret_sample_item(lds, PROJ, OG, ap->in[2] + li * SRS_L, X + O_SRS + li * SRS_L, it, tid);
#endif
            }
            GSYNC();
            {
            PHASE_PTRS();
            ret_normalize(PROJ, OG, (const float*)(ws + WS_GN), bid, G, tid);
            }
        } else {
#ifndef SKIP_ATTN
            for (int rep = 0; rep < REP_ATTN; ++rep) {
            PHASE_PTRS();
            const float* sinks = ap->in[12] + li * 16;
            for (int it = bid; it < NB * 32 * HKV; it += G) attn_prompt_item(lds, PROJ, OG, sinks, it, tid);
            const int wave = __builtin_amdgcn_readfirstlane(tid >> 6);
            for (int it0 = bid * 2; it0 < DECB * HKV; it0 += 2 * G) {
                const int it = it0 + (wave >> 2);
                attn_sample_load(lds + (wave >> 2) * 46080, PROJ, ap->in[3] + li * CS_L, ap->in[4] + li * CS_L, it, wave & 3, tid & 63);
                __syncthreads();
                if ((wave & 3) == 0) attn_sample_compute(lds + (wave >> 2) * 46080, PROJ, OG, sinks, it, tid & 63);
                __syncthreads();
            }
            __syncthreads();
            }
#endif
            __syncthreads();
        }
        GSYNC();
#ifndef SKIP_G2
        {
            PHASE_PTRS();
            pg8::Gemm g{OG, isret ? (const bf16*)(ws + WS_ROUT) + (size_t)li * D * RO : (const bf16*)(ws + WS_WO) + (size_t)li * D * D, MP, D, isret ? RO : D};
            pg8::StaticOrder S; S.init(MP, D, G, bid);
            const float* Xp = L == 0 ? ap->in[0] : X; const float* Xs = L == 0 ? ap->in[1] - (size_t)MP * D : X;
            EpiRes E{Xp, X, XB, SSQ};
            pg8::gemm_phase<EpiRes, pg8::StaticOrder, true, true>(lds, g, S, E);
            for (int t = bid; t < 256; t += G) mini_res_tile(lds, g.A, g.Bt, g.K, Xs, X, XB, SSQ, t, tid);
        }
#endif
        GSYNC();
#ifndef SKIP_G3
        {
            PHASE_PTRS();
            pg8::Gemm g{XB, (const bf16*)(ws + WS_UP) + (size_t)L * FF * D, M, FF, D}; pg8::StaticOrder S; S.init(M, FF, G, bid);
            EpiUp E{ACT, SSQ};
            pg8::gemm_phase<EpiUp, pg8::StaticOrder, true, true>(lds, g, S, E);
            if constexpr (L == 3) {
                const int busy = (M / 256) * (FF / 256) % G;
                if (bid >= busy) copy_sample_caches(ap->in, X, (bid - busy) * NT + tid, (G - busy) * NT);
            }
            if constexpr (L < 3) {
                const int busy = (M / 256) * (FF / 256) % G;
                if (bid >= busy && busy > 0) convert_layer_weights(ap->in, ws, L + 1, (LAS float*)(lds + (tid >> 6) * 16384), (bid - busy) * 8 + (tid >> 6), (G - busy) * 8, tid & 63);
                else if (busy == 0) convert_layer_weights(ap->in, ws, L + 1, (LAS float*)(lds + (tid >> 6) * 16384), bid * 8 + (tid >> 6), G * 8, tid & 63);
                __syncthreads();
            }
        }
#endif
        GSYNC();
#ifndef SKIP_G4
        {
            PHASE_PTRS();
            pg8::Gemm g{ACT, (const bf16*)(ws + WS_DN) + (size_t)L * D * FF, MP, D, FF}; pg8::StaticOrder S; S.init(MP, D, G, bid);
            EpiRes E{X, X, XB, SSQ};
            pg8::gemm_phase<EpiRes, pg8::StaticOrder, true, true>(lds, g, S, E);
            for (int t = bid; t < 256; t += G) mini_res_tile(lds, g.A, g.Bt, g.K, X, X, XB, SSQ, t, tid);
        }
#endif
        if (L < 3) GSYNC();
}

__global__ void __launch_bounds__(NT, 2) hybrid_fwd(Args a) {
    extern __shared__ __attribute__((aligned(16))) unsigned char lds_raw[];
    LAS unsigned char* lds = (LAS unsigned char*)lds_raw;
    cg::grid_group grid = cg::this_grid();
    grid.sync();
    if (threadIdx.x < 16) ((LAS unsigned*)(lds + BAR_LDS_OFF))[threadIdx.x] = 0u;
    __syncthreads();
    (void)xcd_barrier_post((unsigned*)a.ws, (volatile LAS unsigned*)(lds + BAR_LDS_OFF));
#ifndef SKIP_P0
    for (int rep = 0; rep < REP_P0; ++rep) { p0_prologue(a, lds, blockIdx.x, gridDim.x, threadIdx.x); __syncthreads(); }
#endif
    GSYNC();

    run_layer<0>(grid, lds); run_layer<1>(grid, lds); run_layer<2>(grid, lds); run_layer<3>(grid, lds);
}

extern "C" void kernel_launch(void* const* d_in, const int* in_sizes, int n_in, void* d_out, int out_size, void* d_ws, size_t ws_size, hipStream_t stream) {
    static int grid = 0;
    if (grid == 0) {
        if (n_in != 16 || ws_size < WS_END) { fprintf(stderr, "kernel_launch: unexpected inputs (n_in %d, ws %zu)\n", n_in, ws_size); grid = -1; return; }
        int dev = 0, cus = 0, per_cu = 0;
        if (hipGetDevice(&dev) != hipSuccess || hipDeviceGetAttribute(&cus, hipDeviceAttributeMultiprocessorCount, dev) != hipSuccess) { grid = -1; return; }
        if (hipFuncSetAttribute((const void*)hybrid_fwd, hipFuncAttributeMaxDynamicSharedMemorySize, LDS_BYTES) != hipSuccess) { fprintf(stderr, "kernel_launch: hipFuncSetAttribute failed\n"); grid = -1; return; }
        if (hipOccupancyMaxActiveBlocksPerMultiprocessor(&per_cu, (const void*)hybrid_fwd, NT, LDS_BYTES) != hipSuccess || per_cu < 1) { fprintf(stderr, "kernel_launch: occupancy query says %d\n", per_cu); per_cu = 1; }
        (void)hipGetLastError();
        grid = cus;
    }
    if (grid < 0) return;
    if (hipMemsetAsync(d_ws, 0, 32768, stream) != hipSuccess) { fprintf(stderr, "kernel_launch: memset of the barrier words failed\n"); return; }
    Args a{};
    for (int i = 0; i < 16; ++i) a.in[i] = (const float*)d_in[i];
    a.out = (float*)d_out; a.ws = (unsigned char*)d_ws;
    void* args[] = {&a};
    hipError_t e = hipLaunchCooperativeKernel((const void*)hybrid_fwd, dim3(grid), dim3(NT), args, LDS_BYTES, stream);
    if (e != hipSuccess) fprintf(stderr, "kernel_launch: cooperative launch failed: %s (grid %d)\n", hipGetErrorString(e), grid);
}
```

```cpp
#include <hip/hip_runtime.h>
#include <hip/hip_cooperative_groups.h>
#include <cstdio>
#include <cstdint>
namespace cg = cooperative_groups;
namespace pg8 {
#define PG8_LAS __attribute__((address_space(3)))
typedef unsigned short bf16_t;
typedef short bf16x8 __attribute__((ext_vector_type(8)));
typedef float f32x4 __attribute__((ext_vector_type(4)));
typedef unsigned u32x4 __attribute__((ext_vector_type(4)));
constexpr int BM = 256, BK = 64, HALF = 128, HTB = HALF * BK * 2  , STAGE_BYTES = 8 * HTB, NXCD = 8, WGM = 8;

__host__ __device__ __forceinline__ int lds_byte(int r, int c) { const int st = (r >> 4) * 2 + (c >> 5), rr = r & 15, cc = c & 31, ob = rr * 64 + cc * 2; return st * 1024 + (ob ^ (((ob >> 9) & 1) << 5)); }
__host__ __device__ __forceinline__ void stage_rc(int b, int& R, int& C) { const int st = b / 1024, sb = b % 1024, swz = sb ^ (((sb >> 9) & 1) << 5); R = (st >> 1) * 16 + swz / 64; C = (st & 1) * 32 + (swz % 64) / 2; }
__host__ __device__ __forceinline__ int perm32(int rho) { const int n = rho >> 4, i = rho & 15; return 8 * (i >> 2) + 4 * n + (i & 3); }

struct Unit { int pm, pn; };
struct Gemm { const bf16_t* A; const bf16_t* Bt; int M, N, K; };

struct StaticOrder {
    int nM, nN, nwg, G, c;
    __host__ __device__ void init(int M, int N, int G_, int c_) { nM = M / BM; nN = N / BM; nwg = nM * nN; G = G_; c = c_; }
    __host__ __device__ bool next(int i, Unit& u) const {
        const long L = (long)i * G + c; if (L >= nwg) return false;
        int wgid = (int)L; { const int q = nwg / NXCD, r = nwg % NXCD, xcd = wgid % NXCD, off = wgid / NXCD; wgid = (xcd < r ? xcd * (q + 1) : r * (q + 1) + (xcd - r) * q) + off; }
        const int nig = WGM * nN, gid = wgid / nig, fm = gid * WGM, gsz = (nM - fm) < WGM ? (nM - fm) : WGM;
        u.pm = fm + ((wgid % nig) % gsz); u.pn = (wgid % nig) / gsz; return true;
    }
    __device__ __forceinline__ void a_ready(const Unit&) const {}
    __device__ __forceinline__ void done(const Unit&) const {}
};

__device__ __forceinline__ unsigned cvt_pk_bf16(float lo, float hi) { typedef float f2 __attribute__((ext_vector_type(2))); typedef __bf16 b2 __attribute__((ext_vector_type(2))); f2 v = {lo, hi}; b2 b = __builtin_convertvector(v, b2); return __builtin_bit_cast(unsigned, b); }
template <class Epi, class Sched, bool ALIGN_EPI = false, bool SP2 = false>
__device__ __forceinline__ void gemm_phase(PG8_LAS unsigned char* lds, const Gemm g, const Sched& S, const Epi& E) {
    int tid = threadIdx.x; asm volatile("" : "+v"(tid));
    const int wid = __builtin_amdgcn_readfirstlane(tid >> 6), lane = tid & 63, wr = wid >> 2, wc = wid & 3, fr = lane & 15, fq = lane >> 4;
    const int K = g.K, nt = K / BK;
    unsigned voffA[2], voffB[2];
#pragma unroll
    for (int i = 0; i < 2; ++i) { int R, C; stage_rc(tid * 16 + i * 8192, R, C); const int Rb = Epi::PERM ? ((R & ~31) + perm32(R & 31)) : R;
        voffA[i] = (unsigned)(R * K + C) * 2u; voffB[i] = (unsigned)(Rb * K + C) * 2u; }
    const size_t kstep = (size_t)(BK * 2);
    const size_t hstep = (size_t)HALF * K * 2;
    const size_t tstep = 2 * hstep;
    const unsigned ldsw = (unsigned)wid * 1024u;
    const int aoff = lds_byte(wr * 64 + fr, fq * 8), boff = lds_byte(wc * 32 + fr, fq * 8);
#define PG8_SA(b, h) (((b) * 2 + (h)) * HTB)
#define PG8_SB(b, h) ((4 + (b) * 2 + (h)) * HTB)
#define PG8_STAGE(bufoff, gbase, voff) do { _Pragma("unroll") for (int _i = 0; _i < 2; ++_i) \
        __builtin_amdgcn_global_load_lds((const unsigned*)((const char*)(gbase) + (voff)[_i]), (PG8_LAS unsigned*)(lds + (bufoff) + ldsw + _i * 8192), 16, 0, 0); } while (0)
#define PG8_LDA(dst, b, h) do { _Pragma("unroll") for (int m = 0; m < 4; ++m) _Pragma("unroll") for (int k = 0; k < 2; ++k) dst[m][k] = *(const PG8_LAS bf16x8*)(lds + PG8_SA(b, h) + aoff + m * 2048 + k * 1024); } while (0)
#define PG8_LDB(dst, b, h) do { _Pragma("unroll") for (int n = 0; n < 2; ++n) _Pragma("unroll") for (int k = 0; k < 2; ++k) dst[n][k] = *(const PG8_LAS bf16x8*)(lds + PG8_SB(b, h) + boff + n * 2048 + k * 1024); } while (0)
#define PG8_MMA(ai, bj, At, Bt) do { __builtin_amdgcn_s_setprio(1); _Pragma("unroll") for (int m = 0; m < 4; ++m) _Pragma("unroll") for (int n = 0; n < 2; ++n) _Pragma("unroll") for (int k = 0; k < 2; ++k) \
        acc[ai][bj][m][n] = __builtin_amdgcn_mfma_f32_16x16x32_bf16(Bt[n][k], At[m][k], acc[ai][bj][m][n], 0, 0, 0); __builtin_amdgcn_s_setprio(0); } while (0)
#define PG8_WAIT_V(n) asm volatile("s_waitcnt vmcnt(" #n ")" ::: "memory")
#define PG8_WAIT_L(n) asm volatile("s_waitcnt lgkmcnt(" #n ")" ::: "memory")
#define PG8_BAR __builtin_amdgcn_s_barrier()
#define PG8_SCHED __builtin_amdgcn_sched_barrier(0)
    Unit cur, nxt; int ui = 0;
    if (!S.next(0, cur)) return;
    f32x4 acc[2][2][4][2];
#pragma unroll
    for (int a = 0; a < 2; ++a)
#pragma unroll
        for (int b = 0; b < 2; ++b)
#pragma unroll
            for (int m = 0; m < 4; ++m)
#pragma unroll
                for (int n = 0; n < 2; ++n) acc[a][b][m][n] = (f32x4){0.f, 0.f, 0.f, 0.f};
    bf16x8 At[4][2], B0[2][2], B1[2][2];
    const char* cA = (const char*)g.A + (size_t)cur.pm * tstep; const char* cB = (const char*)g.Bt + (size_t)cur.pn * tstep;
    S.a_ready(cur);
    if constexpr (SP2) {
        PG8_STAGE(PG8_SB(0, 0), cB, voffB); PG8_STAGE(PG8_SB(0, 1), cB + hstep, voffB); PG8_STAGE(PG8_SA(0, 0), cA, voffA); PG8_STAGE(PG8_SA(0, 1), cA + hstep, voffA);
        if (wr == 1) PG8_BAR;
        PG8_WAIT_V(2); PG8_BAR;
        PG8_STAGE(PG8_SB(1, 0), cB + kstep, voffB); PG8_STAGE(PG8_SA(1, 0), cA + kstep, voffA); PG8_STAGE(PG8_SB(1, 1), cB + hstep + kstep, voffB);
        PG8_WAIT_V(6); PG8_BAR;
    } else {
        PG8_STAGE(PG8_SB(0, 0), cB, voffB); PG8_STAGE(PG8_SA(0, 0), cA, voffA); PG8_STAGE(PG8_SB(0, 1), cB + hstep, voffB); PG8_STAGE(PG8_SA(0, 1), cA + hstep, voffA);
        if (wr == 1) PG8_BAR;
        PG8_WAIT_V(4); PG8_BAR;
        PG8_STAGE(PG8_SB(1, 0), cB + kstep, voffB); PG8_STAGE(PG8_SA(1, 0), cA + kstep, voffA); PG8_STAGE(PG8_SB(1, 1), cB + hstep + kstep, voffB);
        PG8_WAIT_V(6); PG8_BAR;
    }
    for (;;) {
        const bool has_next = S.next(ui + 1, nxt);
        const char* nA = has_next ? (const char*)g.A + (size_t)nxt.pm * tstep : cA; const char* nB = has_next ? (const char*)g.Bt + (size_t)nxt.pn * tstep : cB;
        for (int t = 0; t < nt; t += 2) {
            const bool last = (t == nt - 2);
            const char* a1 = cA + (size_t)(t + 1) * kstep;
            const char* a2 = last ? nA : cA + (size_t)(t + 2) * kstep; const char* b2 = last ? nB : cB + (size_t)(t + 2) * kstep;
            const char* a3 = a2 + kstep; const char* b3 = b2 + kstep;
            if (last && has_next) S.a_ready(nxt);
            if constexpr (SP2) {
            PG8_LDB(B0, 0, 0); PG8_LDB(B1, 0, 1); PG8_SCHED; PG8_LDA(At, 0, 0); PG8_STAGE(PG8_SA(1, 1), a1 + hstep, voffA);
            PG8_WAIT_V(8); PG8_WAIT_L(0); PG8_BAR; PG8_MMA(0, 0, At, B0); PG8_MMA(0, 1, At, B1); PG8_BAR; PG8_SCHED;
            PG8_LDA(At, 0, 1); PG8_STAGE(PG8_SB(0, 0), b2, voffB); PG8_STAGE(PG8_SB(0, 1), b2 + hstep, voffB); PG8_STAGE(PG8_SA(0, 0), a2, voffA);
            PG8_WAIT_V(8); PG8_WAIT_L(0); PG8_BAR; PG8_MMA(1, 0, At, B0); PG8_MMA(1, 1, At, B1); PG8_BAR; PG8_SCHED;
            PG8_LDB(B0, 1, 0); PG8_LDB(B1, 1, 1); PG8_SCHED; PG8_LDA(At, 1, 0); PG8_STAGE(PG8_SA(0, 1), a2 + hstep, voffA);
            PG8_WAIT_V(8); PG8_WAIT_L(0); PG8_BAR; PG8_MMA(0, 0, At, B0); PG8_MMA(0, 1, At, B1); PG8_BAR; PG8_SCHED;
            PG8_LDA(At, 1, 1); PG8_STAGE(PG8_SB(1, 0), b3, voffB); PG8_STAGE(PG8_SB(1, 1), b3 + hstep, voffB); PG8_STAGE(PG8_SA(1, 0), a3, voffA);
            PG8_WAIT_V(8); PG8_WAIT_L(0); PG8_BAR; PG8_MMA(1, 0, At, B0); PG8_MMA(1, 1, At, B1); PG8_BAR; PG8_SCHED;
            } else {
            PG8_LDB(B0, 0, 0); PG8_SCHED; PG8_LDA(At, 0, 0); PG8_STAGE(PG8_SA(1, 1), a1 + hstep, voffA);
            PG8_WAIT_L(8); PG8_BAR; PG8_WAIT_L(0); PG8_MMA(0, 0, At, B0); PG8_BAR; PG8_SCHED;
            PG8_LDB(B1, 0, 1); PG8_STAGE(PG8_SB(0, 0), b2, voffB);
            PG8_BAR; PG8_WAIT_L(0); PG8_MMA(0, 1, At, B1); PG8_BAR;
            PG8_LDA(At, 0, 1); PG8_STAGE(PG8_SA(0, 0), a2, voffA);
            PG8_BAR; PG8_WAIT_L(0); PG8_MMA(1, 0, At, B0); PG8_BAR; PG8_SCHED;
            PG8_STAGE(PG8_SB(0, 1), b2 + hstep, voffB);
            PG8_WAIT_V(6); PG8_BAR; PG8_MMA(1, 1, At, B1); PG8_BAR;
            PG8_LDB(B0, 1, 0); PG8_SCHED; PG8_LDA(At, 1, 0); PG8_STAGE(PG8_SA(0, 1), a2 + hstep, voffA);
            PG8_WAIT_L(8); PG8_BAR; PG8_WAIT_L(0); PG8_MMA(0, 0, At, B0); PG8_BAR; PG8_SCHED;
            PG8_LDB(B1, 1, 1); PG8_STAGE(PG8_SB(1, 0), b3, voffB);
            PG8_BAR; PG8_WAIT_L(0); PG8_MMA(0, 1, At, B1); PG8_BAR;
            PG8_LDA(At, 1, 1); PG8_STAGE(PG8_SA(1, 0), a3, voffA);
            PG8_BAR; PG8_WAIT_L(0); PG8_MMA(1, 0, At, B0); PG8_BAR; PG8_SCHED;
            PG8_STAGE(PG8_SB(1, 1), b3 + hstep, voffB);
            PG8_WAIT_V(6); PG8_BAR; PG8_MMA(1, 1, At, B1); PG8_BAR;
            }
        }
        if constexpr (ALIGN_EPI) { if (wr == 0) PG8_BAR; }
        if constexpr (!Epi::AFTER_DRAIN) { E(acc, cur, wr, wc, fr, fq); S.done(cur); }
        if (!has_next) break;
#pragma unroll
        for (int a = 0; a < 2; ++a)
#pragma unroll
            for (int b = 0; b < 2; ++b)
#pragma unroll
                for (int m = 0; m < 4; ++m)
#pragma unroll
                    for (int n = 0; n < 2; ++n) acc[a][b][m][n] = (f32x4){0.f, 0.f, 0.f, 0.f};
        cur = nxt; cA = nA; cB = nB; ++ui;
        if constexpr (ALIGN_EPI) { if (wr == 1) PG8_BAR; }
    }
    PG8_WAIT_V(0);
    if constexpr (!ALIGN_EPI) { if (wr == 0) PG8_BAR; }
    PG8_BAR;
    if constexpr (Epi::AFTER_DRAIN) { E.fused(acc, cur, wr, wc, fr, fq, lds, wid, lane); S.done(cur); }
#undef PG8_SA
#undef PG8_SB
#undef PG8_STAGE
#undef PG8_LDA
#undef PG8_LDB
#undef PG8_MMA
#undef PG8_WAIT_V
#undef PG8_WAIT_L
#undef PG8_BAR
#undef PG8_SCHED
}
}

#define LAS __attribute__((address_space(3)))
typedef unsigned short bf16;
typedef float f32x4 __attribute__((ext_vector_type(4)));
typedef unsigned u32x4 __attribute__((ext_vector_type(4)));
typedef unsigned u32x2 __attribute__((ext_vector_type(2)));
typedef short bf16x8 __attribute__((ext_vector_type(8)));
typedef short s16x4 __attribute__((ext_vector_type(4)));
typedef short v4i16_t __attribute__((ext_vector_type(4)));

constexpr int D = 1024, SEQ = 4096, NB = 4, MP = NB * SEQ, DECB = 128, DECT = 4, MS = DECB * DECT, M = MP + MS;
constexpr int PAST = 8192;
constexpr int RH = 4, RDK = 256, RDV = 512, RN = 6144, RO = 2048;
constexpr int HKV = 4, DH = 64, SN = 1536, WIN = 128;
constexpr int FF = 4096;
constexpr float EPS = 1e-6f;
constexpr int NPOS = SEQ + DECT;
constexpr int NT = 512;
constexpr int LDS_BYTES = 147456;
#ifndef REP_RET
#define REP_RET 1
#endif
#ifndef REP_ATTN
#define REP_ATTN 1
#endif
#ifndef REP_P0
#define REP_P0 1
#endif

constexpr size_t O_YS = (size_t)MP * D, O_SRP = O_YS + (size_t)MS * D, SRP_L = (size_t)NB * RH * RDK * RDV;
constexpr size_t O_CKP = O_SRP + 2 * SRP_L, CP_L = (size_t)NB * WIN * HKV * DH, O_CVP = O_CKP + 2 * CP_L;
constexpr size_t O_SRS = O_CVP + 2 * CP_L, SRS_L = (size_t)DECB * RH * RDK * RDV;
constexpr size_t O_CKS = O_SRS + 2 * SRS_L, CS_L = (size_t)DECB * WIN * HKV * DH, O_CVS = O_CKS + 2 * CS_L;
constexpr size_t MiB = 1u << 20;
constexpr size_t WS_RIN = 1 * MiB, WS_ROUT = 25 * MiB, WS_QKV = 33 * MiB, WS_WO = 39 * MiB, WS_UP = 43 * MiB, WS_DN = 75 * MiB;
constexpr size_t WS_XB = 107 * MiB, WS_SSQ = 140 * MiB, WS_GN = 142 * MiB, WS_TABR = 145 * MiB, WS_TABS = 150 * MiB;
constexpr size_t WS_PROJ = 152 * MiB, WS_OG = 350 * MiB, WS_ACT = 416 * MiB, WS_END = 548 * MiB;

__device__ __forceinline__ unsigned pk2(float lo, float hi) { return pg8::cvt_pk_bf16(lo, hi); }
__device__ __forceinline__ float bflo(unsigned u) { return __uint_as_float(u << 16); }
__device__ __forceinline__ float bfhi(unsigned u) { return __uint_as_float(u & 0xffff0000u); }
__device__ __forceinline__ float bf2f(bf16 b) { return __uint_as_float(((unsigned)b) << 16); }
__device__ __forceinline__ float wave_sum(float v) {
#pragma unroll
    for (int o = 1; o < 64; o <<= 1) v += __shfl_xor(v, o);
    return v;
}
__device__ __forceinline__ float uni(float x) { return __uint_as_float(__builtin_amdgcn_readfirstlane(__float_as_uint(x))); }
__device__ __forceinline__ float dot4(f32x4 a) { return (a.x * a.x + a.y * a.y) + (a.z * a.z + a.w * a.w); }
__device__ __forceinline__ s16x4 vtr(LAS const unsigned char* p) { return __builtin_bit_cast(s16x4, __builtin_amdgcn_ds_read_tr16_b64_v4i16((LAS v4i16_t*)p)); }
__device__ __forceinline__ bf16x8 cat8(s16x4 lo, s16x4 hi) { return (bf16x8){lo[0], lo[1], lo[2], lo[3], hi[0], hi[1], hi[2], hi[3]}; }
__device__ __forceinline__ bf16x8 packp(f32x4 a, f32x4 b) { u32x4 w; w.x = pk2(a.x, a.y); w.y = pk2(a.z, a.w); w.z = pk2(b.x, b.y); w.w = pk2(b.z, b.w); return __builtin_bit_cast(bf16x8, w); }
#define MFMA16(a, b, c) __builtin_amdgcn_mfma_f32_16x16x32_bf16(a, b, c, 0, 0, 0)

__device__ __forceinline__ float row_rs(const float* SSQ, int row) {
    const f32x4* p = (const f32x4*)(SSQ + (size_t)row * 16);
    const f32x4 a = p[0], b = p[1], c = p[2], d = p[3];
    const float s = (((a.x + a.y) + (a.z + a.w)) + ((b.x + b.y) + (b.z + b.w))) + (((c.x + c.y) + (c.z + c.w)) + ((d.x + d.y) + (d.z + d.w)));
    return rsqrtf(s * (1.0f / 1024.0f) + EPS);
}
__device__ __forceinline__ void row_rs8(const float* SSQ, int row_base  , int fq, float (&rs)[2][4]) {
    f32x4 p[2][4];
#pragma unroll
    for (int ai = 0; ai < 2; ++ai)
#pragma unroll
        for (int m = 0; m < 4; ++m) p[ai][m] = *(const f32x4*)(SSQ + (size_t)(row_base + ai * 128 + m * 16) * 16 + 4 * fq);
#pragma unroll
    for (int ai = 0; ai < 2; ++ai)
#pragma unroll
        for (int m = 0; m < 4; ++m) {
            float s = (p[ai][m].x + p[ai][m].y) + (p[ai][m].z + p[ai][m].w);
            s += __shfl_xor(s, 16); s += __shfl_xor(s, 32);
            rs[ai][m] = rsqrtf(s * (1.0f / 1024.0f) + EPS);
        }
}
__device__ __forceinline__ int pos_index(int row) { return row < MP ? (row & (SEQ - 1)) : SEQ + ((row - MP) & 3); }

struct EpiRes {
    static constexpr bool PERM = true, AFTER_DRAIN = false;
    const float* Xin; float* X; bf16* XB; float* SSQ;
    __device__ __forceinline__ void operator()(const pg8::f32x4 (&acc)[2][2][4][2], const pg8::Unit& u, int wr, int wc, int fr, int fq) const {
#pragma unroll
        for (int ai = 0; ai < 2; ++ai)
#pragma unroll
            for (int m = 0; m < 4; ++m) {
                const int row = u.pm * 256 + ai * 128 + wr * 64 + m * 16 + fr;
                float ss = 0.f;
#pragma unroll
                for (int bj = 0; bj < 2; ++bj) {
                    const int col = u.pn * 256 + bj * 128 + wc * 32 + 8 * fq;
                    float* xp = X + (size_t)row * D + col; const float* xi = Xin + (size_t)row * D + col;
                    const f32x4 a = *(const f32x4*)xi + acc[ai][bj][m][0], b = *(const f32x4*)(xi + 4) + acc[ai][bj][m][1];
                    *(f32x4*)xp = a; *(f32x4*)(xp + 4) = b;
                    ss += dot4(a) + dot4(b);
                    u32x4 w; w.x = pk2(a.x, a.y); w.y = pk2(a.z, a.w); w.z = pk2(b.x, b.y); w.w = pk2(b.z, b.w);
                    *(u32x4*)(XB + (size_t)row * D + col) = w;
                }
                ss += __shfl_xor(ss, 16); ss += __shfl_xor(ss, 32);
                if (fq == 0) SSQ[(size_t)row * 16 + u.pn * 4 + wc] = ss;
                if (m & 1) asm volatile("" ::: "memory");
            }
    }
};
struct EpiUp {
    static constexpr bool PERM = true, AFTER_DRAIN = false;
    bf16* ACT; const float* SSQ;
    __device__ __forceinline__ void operator()(const pg8::f32x4 (&acc)[2][2][4][2], const pg8::Unit& u, int wr, int wc, int fr, int fq) const {
        const int rb = u.pm * 256 + wr * 64 + fr;
        float rsv[2][4]; row_rs8(SSQ, rb, fq, rsv);
#pragma unroll
        for (int ai = 0; ai < 2; ++ai)
#pragma unroll
            for (int m = 0; m < 4; ++m) {
                const int row = rb + ai * 128 + m * 16;
                const float rs = rsv[ai][m];
#pragma unroll
                for (int bj = 0; bj < 2; ++bj) {
                    const int col = u.pn * 256 + bj * 128 + wc * 32 + 8 * fq;
                    f32x4 a = acc[ai][bj][m][0] * rs, b = acc[ai][bj][m][1] * rs;
                    a = __builtin_elementwise_max(a, (f32x4){0.f, 0.f, 0.f, 0.f}); b = __builtin_elementwise_max(b, (f32x4){0.f, 0.f, 0.f, 0.f});
                    a = a * a; b = b * b;
                    u32x4 w; w.x = pk2(a.x, a.y); w.y = pk2(a.z, a.w); w.z = pk2(b.x, b.y); w.w = pk2(b.z, b.w);
                    *(u32x4*)(ACT + (size_t)row * FF + col) = w;
                }
            }
    }
};
__device__ __forceinline__ void rope4(const f32x4 x1, const f32x4 x2, const f32x4 t0, const f32x4 t1, f32x4& o1, f32x4& o2) {
    o1.x = x1.x * t0.x - x2.x * t0.y; o2.x = x2.x * t0.x + x1.x * t0.y;
    o1.y = x1.y * t0.z - x2.y * t0.w; o2.y = x2.y * t0.z + x1.y * t0.w;
    o1.z = x1.z * t1.x - x2.z * t1.y; o2.z = x2.z * t1.x + x1.z * t1.y;
    o1.w = x1.w * t1.z - x2.w * t1.w; o2.w = x2.w * t1.z + x1.w * t1.w;
}
__device__ __forceinline__ float silu1(float v) { return v / (1.0f + __expf(-v)); }
struct EpiRetIn {
    static constexpr bool PERM = true, AFTER_DRAIN = false;
    bf16* P; const float* SSQ; const float* TAB; int row_off;
    __device__ __forceinline__ void operator()(const pg8::f32x4 (&acc)[2][2][4][2], const pg8::Unit& u, int wr, int wc, int fr, int fq) const {
        const int pn = u.pn;
        const int rb = row_off + u.pm * 256 + wr * 64 + fr;
        float rsv[2][4]; row_rs8(SSQ, rb, fq, rsv);
#pragma unroll
        for (int ai = 0; ai < 2; ++ai) {
            if (pn < 8) {
#pragma unroll
                for (int mh = 0; mh < 2; ++mh) {
                f32x4 tb[4][4];
#pragma unroll
                for (int m = 2 * mh; m < 2 * mh + 2; ++m) { const f32x4* tp = (const f32x4*)(TAB + ((size_t)pos_index(rb + ai * 128 + m * 16) * 128 + wc * 32 + 8 * fq) * 2);
#pragma unroll
                    for (int q = 0; q < 4; ++q) tb[m][q] = tp[q]; }
#pragma unroll
                for (int m = 2 * mh; m < 2 * mh + 2; ++m) {
                    const int row = rb + ai * 128 + m * 16;
                    const float sc = pn >= 4 ? rsv[ai][m] * 0.0625f : rsv[ai][m];
                    bf16* prow = P + (size_t)row * RN + pn * 256 + wc * 32 + 8 * fq;
                    u32x4 w1, w2;
#pragma unroll
                    for (int n = 0; n < 2; ++n) {
                        f32x4 o1, o2; rope4(acc[ai][0][m][n] * sc, acc[ai][1][m][n] * sc, tb[m][2 * n], tb[m][2 * n + 1], o1, o2);
                        w1[2 * n] = pk2(o1.x, o1.y); w1[2 * n + 1] = pk2(o1.z, o1.w); w2[2 * n] = pk2(o2.x, o2.y); w2[2 * n + 1] = pk2(o2.z, o2.w);
                    }
                    *(u32x4*)prow = w1; *(u32x4*)(prow + 128) = w2;
                }
                asm volatile("" ::: "memory");
                }
            } else {
#pragma unroll
                for (int m = 0; m < 4; ++m) {
                    const int row = rb + ai * 128 + m * 16;
                    const float rs = rsv[ai][m];
                    bf16* prow = P + (size_t)row * RN + pn * 256 + wc * 32 + 8 * fq;
#pragma unroll
                    for (int bj = 0; bj < 2; ++bj) {
                        f32x4 a = acc[ai][bj][m][0] * rs, b = acc[ai][bj][m][1] * rs;
                        if (pn >= 16) { a.x = silu1(a.x); a.y = silu1(a.y); a.z = silu1(a.z); a.w = silu1(a.w); b.x = silu1(b.x); b.y = silu1(b.y); b.z = silu1(b.z); b.w = silu1(b.w); }
                        u32x4 w; w.x = pk2(a.x, a.y); w.y = pk2(a.z, a.w); w.z = pk2(b.x, b.y); w.w = pk2(b.z, b.w);
                        *(u32x4*)(prow + bj * 128) = w;
                    }
                }
            }
            asm volatile("" ::: "memory");
        }
    }
};
struct EpiSwaQkv {
    static constexpr bool PERM = true, AFTER_DRAIN = false;
    bf16* P; const float* SSQ; const float* TAB; const float* qn; const float* kn; float* ckp; float* cvp; float* cks; float* cvs;
    __device__ __forceinline__ float* cache_dst(float* cp, float* cs, int row, int kvh) const {
        if (row < MP) { const int t = row & (SEQ - 1); if (t < SEQ - WIN) return nullptr; return cp + (((size_t)(row >> 12) * WIN + (t - (SEQ - WIN))) * HKV + kvh) * DH; }
        const int rr = row - MP; return cs + (((size_t)(rr >> 2) * WIN + (WIN - DECT) + (rr & 3)) * HKV + kvh) * DH;
    }
    __device__ __forceinline__ void operator()(const pg8::f32x4 (&acc)[2][2][4][2], const pg8::Unit& u, int wr, int wc, int fr, int fq) const {
        const int pn = u.pn;
        float rsv[2][4]; row_rs8(SSQ, u.pm * 256 + wr * 64 + fr, fq, rsv);
        if (pn < 5) {
            const float* nw = pn < 4 ? qn : kn;
            f32x4 nwv[2][2];
#pragma unroll
            for (int bj = 0; bj < 2; ++bj)
#pragma unroll
                for (int n = 0; n < 2; ++n) nwv[bj][n] = *(const f32x4*)(nw + 32 * bj + 8 * fq + 4 * n);
#pragma unroll
            for (int ai = 0; ai < 2; ++ai)
#pragma unroll
                for (int m = 0; m < 4; ++m) {
                    const int row = u.pm * 256 + ai * 128 + wr * 64 + m * 16 + fr;
                    const float rs = rsv[ai][m];
                    f32x4 x[2][2]; float ss = 0.f;
#pragma unroll
                    for (int bj = 0; bj < 2; ++bj)
#pragma unroll
                        for (int n = 0; n < 2; ++n) { x[bj][n] = acc[ai][bj][m][n] * rs; ss += dot4(x[bj][n]); }
                    ss += __shfl_xor(ss, 16); ss += __shfl_xor(ss, 32);
                    const float r = rsqrtf(ss * (1.0f / 64.0f) + EPS);
                    const f32x4* tp = (const f32x4*)(TAB + ((size_t)pos_index(row) * 32 + 8 * fq) * 2);
                    u32x4 w1, w2; f32x4 o1[2], o2[2];
#pragma unroll
                    for (int n = 0; n < 2; ++n) {
                        rope4(x[0][n] * r * nwv[0][n], x[1][n] * r * nwv[1][n], tp[2 * n], tp[2 * n + 1], o1[n], o2[n]);
                        w1[2 * n] = pk2(o1[n].x, o1[n].y); w1[2 * n + 1] = pk2(o1[n].z, o1[n].w); w2[2 * n] = pk2(o2[n].x, o2[n].y); w2[2 * n + 1] = pk2(o2[n].z, o2[n].w);
                    }
                    bf16* prow = P + (size_t)row * SN + pn * 256 + wc * 64 + 8 * fq;
                    *(u32x4*)prow = w1; *(u32x4*)(prow + 32) = w2;
                    if (pn == 4) {
                        float* dst = cache_dst(ckp, cks, row, wc);
                        if (dst) { dst += 8 * fq; *(f32x4*)dst = o1[0]; *(f32x4*)(dst + 4) = o1[1]; *(f32x4*)(dst + 32) = o2[0]; *(f32x4*)(dst + 36) = o2[1]; }
                    }
                    if (m & 1) asm volatile("" ::: "memory");
                }
        } else {
#pragma unroll
            for (int ai = 0; ai < 2; ++ai)
#pragma unroll
                for (int m = 0; m < 4; ++m) {
                    const int row = u.pm * 256 + ai * 128 + wr * 64 + m * 16 + fr;
                    const float rs = rsv[ai][m];
#pragma unroll
                    for (int bj = 0; bj < 2; ++bj) {
                        const f32x4 a = acc[ai][bj][m][0] * rs, b = acc[ai][bj][m][1] * rs;
                        u32x4 w; w.x = pk2(a.x, a.y); w.y = pk2(a.z, a.w); w.z = pk2(b.x, b.y); w.w = pk2(b.z, b.w);
                        *(u32x4*)(P + (size_t)row * SN + 1280 + bj * 128 + wc * 32 + 8 * fq) = w;
                        float* dst = cache_dst(cvp, cvs, row, 2 * bj + (wc >> 1));
                        if (dst) { dst += 32 * (wc & 1) + 8 * fq; *(f32x4*)dst = a; *(f32x4*)(dst + 4) = b; }
                    }
                    asm volatile("" ::: "memory");
                }
        }
    }
};

#define XB_TMO      128
#define XB_XCNT(j)  (256  + 64 * (j))
#define XB_XSUB(j)  (1280 + 64 * (j))
#define XB_XGEN(j)  (2304 + 64 * (j))
#define XB_TOP      3328
#define XB_TOPGEN   3392
#define XCD_BAR_WORDS 3456
#define XB_SPIN_CAP (1u << 18)

__device__ __forceinline__ unsigned xb_ld(unsigned* p)              { return __hip_atomic_load(p, __ATOMIC_RELAXED, __HIP_MEMORY_SCOPE_AGENT); }
__device__ __forceinline__ unsigned xb_add(unsigned* p, unsigned v) { return __hip_atomic_fetch_add(p, v, __ATOMIC_RELAXED, __HIP_MEMORY_SCOPE_AGENT); }
__device__ __forceinline__ unsigned xb_xcc_id() { return (unsigned)__builtin_amdgcn_s_getreg((3 << 11) | 20) & 0xFu; }
#define XB_SPIN(cond, bar) do { unsigned _sp = 0; while (cond) { __builtin_amdgcn_s_sleep(1); \
    if ((++_sp & 255u) == 0u) { if (xb_ld(&(bar)[XB_TMO])) break; if (_sp > XB_SPIN_CAP) { atomicAdd(&(bar)[XB_TMO], 1u); break; } } } } while (0)

struct XcdBarrier {
    unsigned* bar; unsigned x;
    volatile LAS unsigned* st;
};

__device__ __forceinline__ XcdBarrier xcd_barrier_post(unsigned* bar, volatile LAS unsigned* st) {
    XcdBarrier b; b.bar = bar; b.x = xb_xcc_id(); b.st = st;
    if (threadIdx.x == 0) (void)xb_add(&bar[XB_XCNT(b.x)], 1u);
    return b;
}
__device__ __forceinline__ void xcd_barrier_complete(unsigned* bar, unsigned x, unsigned& nloc, unsigned& nx) {
    const unsigned G = gridDim.x * gridDim.y * gridDim.z;
    unsigned sum, cnt, mine, sp = 0u;
    for (;;) {
        sum = 0u; cnt = 0u; mine = 0u;
#pragma unroll
        for (unsigned j = 0; j < 16; ++j) { const unsigned c = xb_ld(&bar[XB_XCNT(j)]); sum += c; cnt += (c > 0u) ? 1u : 0u; mine = (j == x) ? c : mine; }
        if (sum == G) break;
        __builtin_amdgcn_s_sleep(1);
        if ((++sp & 255u) == 0u) { if (xb_ld(&bar[XB_TMO])) break; if (sp > XB_SPIN_CAP) { atomicAdd(&bar[XB_TMO], 1u); break; } }
    }
    nloc = mine > 0u ? mine : 1u; nx = cnt > 0u ? cnt : 1u;
}

__device__ __forceinline__ void xcd_barrier(const XcdBarrier& b) {
    asm volatile("s_waitcnt vmcnt(0)" ::: "memory");
    __syncthreads();
    if (threadIdx.x == 0) {
        unsigned* bar = b.bar;
        __builtin_amdgcn_s_waitcnt(0);
        unsigned nloc = b.st[0], nx = b.st[1];
        if (nloc == 0u) { xcd_barrier_complete(bar, b.x, nloc, nx); b.st[0] = nloc; b.st[1] = nx; }
        const unsigned old = xb_add(&bar[XB_XSUB(b.x)], 1u);
        const unsigned gen = old / nloc;
        if (old + 1u == (gen + 1u) * nloc) {
            __builtin_amdgcn_fence(__ATOMIC_RELEASE, "agent");
            asm volatile("s_waitcnt vmcnt(0)" ::: "memory");
            const unsigned og = xb_add(&bar[XB_TOP], 1u);
            const unsigned tg = og / nx;
            if (og + 1u == (tg + 1u) * nx) xb_add(&bar[XB_TOPGEN], 1u);
            else XB_SPIN(xb_ld(&bar[XB_TOPGEN]) == tg, bar);
            __builtin_amdgcn_fence(__ATOMIC_ACQUIRE, "agent");
            xb_add(&bar[XB_XGEN(b.x)], 1u);
            asm volatile("s_waitcnt vmcnt(0)" ::: "memory");
        } else {
            XB_SPIN(xb_ld(&bar[XB_XGEN(b.x)]) == gen, bar);
            __builtin_amdgcn_fence(__ATOMIC_ACQUIRE, "agent");
            asm volatile("s_waitcnt vmcnt(0)" ::: "memory");
        }
    }
    __syncthreads();
}

__device__ __forceinline__ void sub_barrier_once(unsigned* word, unsigned n) {
    asm volatile("s_waitcnt vmcnt(0)" ::: "memory");
    __syncthreads();
    if (threadIdx.x == 0) {
        __builtin_amdgcn_fence(__ATOMIC_RELEASE, "agent");
        asm volatile("s_waitcnt vmcnt(0)" ::: "memory");
        (void)xb_add(word, 1u);
        unsigned sp = 0;
        while (xb_ld(word) < n) { __builtin_amdgcn_s_sleep(2); if (++sp > (1u << 22)) break; }
        __builtin_amdgcn_fence(__ATOMIC_ACQUIRE, "agent");
        asm volatile("s_waitcnt vmcnt(0)" ::: "memory");
    }
    __syncthreads();
}

__device__ __forceinline__ void p0_transpose_item(const float* W, const float* gvec, int K, int N, bf16* WT, int mode, LAS float* scr, int item, int lane) {
    const int nblk = N / 32, kb = item / nblk, nb = item % nblk, k0 = 64 * kb, n0 = 32 * nb;
#pragma unroll 8
    for (int i = 0; i < 32; ++i) { const int kk = 2 * i + (lane >> 5); const float g = gvec ? gvec[k0 + kk] : 1.0f; scr[kk * 33 + (lane & 31)] = W[(size_t)(k0 + kk) * N + n0 + (lane & 31)] * g; }
    asm volatile("s_waitcnt lgkmcnt(0)" ::: "memory");
    int d0 = n0;
    if (mode == 1 && n0 < 1280) { const int pn = n0 >> 8, w = n0 & 255, hh = w >> 6, half = (w >> 5) & 1; d0 = 256 * pn + 128 * half + 32 * hh; }
    const int c = lane & 7;
#pragma unroll
    for (int j = 0; j < 4; ++j) { const int n = (lane >> 3) + 8 * j; const LAS float* s = scr + (8 * c) * 33 + n;
        u32x4 o; o.x = pk2(s[0 * 33], s[1 * 33]); o.y = pk2(s[2 * 33], s[3 * 33]); o.z = pk2(s[4 * 33], s[5 * 33]); o.w = pk2(s[6 * 33], s[7 * 33]);
        *(u32x4*)(WT + (size_t)(d0 + n) * K + k0 + 8 * c) = o; }
    asm volatile("s_waitcnt lgkmcnt(0)" ::: "memory");
}

struct Args { const float* in[16]; float* out; unsigned char* ws; };

template <class PtrTab> __device__ __forceinline__ void convert_layer_weights(PtrTab in, unsigned char* ws, int L, LAS float* scr, int w0, int nw, int lane) {
    constexpr int I_RIN = 16 * 192, I_ROUT = 32 * 32, I_QKV = 16 * 48, I_WO = 16 * 32, I_UP = 16 * 128, I_DN = 64 * 32;
    const int l = L >> 1; const bool isret = !(L & 1);
    const int n_a = isret ? I_RIN : I_QKV, n_b = isret ? I_ROUT : I_WO, total = n_a + n_b + I_UP + I_DN;
    for (int it = w0; it < total; it += nw) {
        int r = it;
        if (r < n_a) { if (isret) p0_transpose_item(in[7] + (size_t)l * D * RN, in[5] + (size_t)L * D, D, RN, (bf16*)(ws + WS_RIN) + (size_t)l * RN * D, 0, scr, r, lane);
                       else p0_transpose_item(in[9] + (size_t)l * D * SN, in[5] + (size_t)L * D, D, SN, (bf16*)(ws + WS_QKV) + (size_t)l * SN * D, 1, scr, r, lane); continue; } r -= n_a;
        if (r < n_b) { if (isret) p0_transpose_item(in[8] + (size_t)l * RO * D, (const float*)nullptr, RO, D, (bf16*)(ws + WS_ROUT) + (size_t)l * D * RO, 0, scr, r, lane);
                       else p0_transpose_item(in[13] + (size_t)l * D * D, (const float*)nullptr, D, D, (bf16*)(ws + WS_WO) + (size_t)l * D * D, 0, scr, r, lane); continue; } r -= n_b;
        if (r < I_UP) { p0_transpose_item(in[14] + (size_t)L * D * FF, in[6] + (size_t)L * D, D, FF, (bf16*)(ws + WS_UP) + (size_t)L * FF * D, 0, scr, r, lane); continue; } r -= I_UP;
        p0_transpose_item(in[15] + (size_t)L * FF * D, (const float*)nullptr, FF, D, (bf16*)(ws + WS_DN) + (size_t)L * D * FF, 0, scr, r, lane);
    }
}

template <class PtrTab> __device__ __forceinline__ void copy_sample_caches(PtrTab in, float* out, int gt, int NGT) {
    {
        constexpr int PER = (WIN - DECT) * HKV * DH / 4;
        constexpr int TOT = 2 * DECB * PER;
        for (int i0 = gt; i0 < 2 * TOT; i0 += 4 * NGT) {
            f32x4 v[4]; float* dst[4];
#pragma unroll
            for (int u = 0; u < 4; ++u) {
                const int i = i0 + u * NGT < 2 * TOT ? i0 + u * NGT : i0;
                const int which = i >= TOT; const int k = which ? i - TOT : i; const int ab = k / PER, r = k - ab * PER;
                v[u] = __builtin_nontemporal_load((const f32x4*)(in[3 + which] + (size_t)ab * (WIN * HKV * DH) + DECT * HKV * DH + (size_t)r * 4));
                dst[u] = out + (which ? O_CVS : O_CKS) + (size_t)ab * (WIN * HKV * DH) + (size_t)r * 4;
            }
#pragma unroll
            for (int u = 0; u < 4; ++u) __builtin_nontemporal_store(v[u], (f32x4*)dst[u]);
        }
    }
}

__device__ __forceinline__ void p0_prologue(const Args& a, LAS unsigned char* lds, int bid, int G, int tid) {
    const int lane = tid & 63, wave = tid >> 6;
    LAS float* scr = (LAS float*)(lds + wave * 16384);
    const int gw = bid * 8 + wave, NGW = G * 8;
    unsigned char* ws = a.ws;
    convert_layer_weights(a.in, ws, 0, scr, gw, NGW, lane);
    bf16* XB = (bf16*)(ws + WS_XB); float* SSQ = (float*)(ws + WS_SSQ);
    for (int m0 = gw; m0 < M; m0 += 2 * NGW) {
        f32x4 v[2][4]; int mm[2];
#pragma unroll
        for (int u = 0; u < 2; ++u) {
            mm[u] = m0 + u * NGW < M ? m0 + u * NGW : m0;
            const float* src = mm[u] < MP ? a.in[0] + (size_t)mm[u] * D : a.in[1] + (size_t)(mm[u] - MP) * D;
#pragma unroll
            for (int j = 0; j < 4; ++j) v[u][j] = __builtin_nontemporal_load((const f32x4*)src + lane + 64 * j);
        }
#pragma unroll
        for (int u = 0; u < 2; ++u) {
            u32x2* brow = (u32x2*)(XB + (size_t)mm[u] * D) + lane;
            float s = 0.f;
#pragma unroll
            for (int j = 0; j < 4; ++j) { s += dot4(v[u][j]); u32x2 w; w.x = pk2(v[u][j].x, v[u][j].y); w.y = pk2(v[u][j].z, v[u][j].w); brow[64 * j] = w; }
            s = wave_sum(s);
            if (lane < 16) SSQ[(size_t)mm[u] * 16 + lane] = lane == 0 ? s : 0.f;
        }
    }
    const int gt = bid * NT + tid, NGT = G * NT;
    float* TABR = (float*)(ws + WS_TABR); float* TABS = (float*)(ws + WS_TABS);
    for (int i = gt; i < NPOS * 160; i += NGT) {
        int p, f, half; float* dst;
        if (i < NPOS * 128) { p = i >> 7; f = i & 127; half = 128; dst = TABR + (size_t)i * 2; }
        else { const int k = i - NPOS * 128; p = k >> 5; f = k & 31; half = 32; dst = TABS + (size_t)k * 2; }
        const int pos = p < SEQ ? p : PAST + (p - SEQ);
        const float inv = exp2f(-((float)f / (float)half) * 13.287712379549449f);
        const double ang = (double)pos * (double)inv;
        const double kq = __builtin_rint(ang * 0.15915494309189535);
        const float rr = (float)(ang - kq * 6.283185307179586);
        dst[0] = cosf(rr); dst[1] = sinf(rr);
    }
}

__device__ __forceinline__ void attn16(LAS const unsigned char* Ks, LAS const unsigned char* Vs, int tile0, int kpos0, const bf16x8 (&qf)[2], int qpos, float sink, f32x4 (&o)[4], float& inv, int lane) {
    const int c = lane & 15, g = lane >> 4, q4 = c >> 2, p4 = c & 3;
    f32x4 s[10];
    float mx = sink;
    bf16x8 Kf[10][2];
#pragma unroll
    for (int tt = 0; tt < 10; ++tt)
#pragma unroll
        for (int ks = 0; ks < 2; ++ks) Kf[tt][ks] = *(LAS const bf16x8*)(Ks + ((16 * (tile0 + tt) + c) * 72 + 32 * ks + 8 * g) * 2);
    __builtin_amdgcn_sched_barrier(0);
#pragma unroll
    for (int tt = 0; tt < 10; ++tt) {
        f32x4 acc = {0.f, 0.f, 0.f, 0.f};
#pragma unroll
        for (int ks = 0; ks < 2; ++ks) acc = MFMA16(Kf[tt][ks], qf[ks], acc);
#pragma unroll
        for (int r = 0; r < 4; ++r) {
            const int kpos = kpos0 + 16 * (tile0 + tt) + 4 * g + r, dd = qpos - kpos;
            const bool ok = dd >= 0 && dd < WIN && kpos >= 0;
            acc[r] = ok ? acc[r] * 0.125f : -1e30f;
            mx = fmaxf(mx, acc[r]);
        }
        s[tt] = acc;
    }
    mx = fmaxf(mx, __shfl_xor(mx, 16)); mx = fmaxf(mx, __shfl_xor(mx, 32));
    float sum = 0.f;
#pragma unroll
    for (int tt = 0; tt < 10; ++tt)
#pragma unroll
        for (int r = 0; r < 4; ++r) { const float p = s[tt][r] > -1e29f ? __expf(s[tt][r] - mx) : 0.f; s[tt][r] = p; sum += p; }
    sum += __shfl_xor(sum, 16); sum += __shfl_xor(sum, 32);
    inv = 1.0f / (sum + __expf(sink - mx));
#pragma unroll
    for (int mt = 0; mt < 4; ++mt) o[mt] = (f32x4){0.f, 0.f, 0.f, 0.f};
    {
        s16x4 vl[5][4], vh[5][4];
#pragma unroll
        for (int tp = 0; tp < 5; ++tp)
#pragma unroll
            for (int mt = 0; mt < 4; ++mt) {
                vl[tp][mt] = vtr(Vs + ((16 * (tile0 + 2 * tp) + 4 * g + q4) * 72 + 16 * mt + 4 * p4) * 2);
                vh[tp][mt] = vtr(Vs + ((16 * (tile0 + 2 * tp + 1) + 4 * g + q4) * 72 + 16 * mt + 4 * p4) * 2);
            }
        __builtin_amdgcn_sched_barrier(0);
#pragma unroll
        for (int tp = 0; tp < 5; ++tp) {
            const bf16x8 pf = packp(s[2 * tp], s[2 * tp + 1]);
#pragma unroll
            for (int mt = 0; mt < 4; ++mt) o[mt] = MFMA16(cat8(vl[tp][mt], vh[tp][mt]), pf, o[mt]);
        }
    }
}

__device__ __forceinline__ void attn_prompt_item(LAS unsigned char* lds, const bf16* P, bf16* OG, const float* sinks, int item, int tid) {
    asm volatile("" : "+v"(tid));
    const int lane = tid & 63, w = __builtin_amdgcn_readfirstlane(tid >> 6), c = lane & 15, g = lane >> 4;
    const int b = item >> 7, blk = (item >> 2) & 31, kvh = item & 3;
    LAS unsigned char* Ks = lds; LAS unsigned char* Vs = lds + 36864;
    const int hq = kvh * 4 + (w >> 1);
    u32x4 kv[4], vv[4]; bf16x8 qa[4][2];
#pragma unroll
    for (int it = 0; it < 4; ++it) {
        const int idx = tid + NT * it, kk = idx >> 3, ch = idx & 7;
        kv[it] = (u32x4){0u, 0u, 0u, 0u}; vv[it] = (u32x4){0u, 0u, 0u, 0u};
        if (blk > 0 || kk >= 128) { const bf16* src = P + (size_t)(b * SEQ + (blk - 1) * 128 + kk) * SN + kvh * 64 + ch * 8; kv[it] = *(const u32x4*)(src + 1024); vv[it] = *(const u32x4*)(src + 1280); }
    }
#pragma unroll
    for (int sb = 0; sb < 4; ++sb)
#pragma unroll
        for (int ks = 0; ks < 2; ++ks) qa[sb][ks] = *(const bf16x8*)(P + (size_t)(b * SEQ + blk * 128 + 64 * (w & 1) + 16 * sb + c) * SN + hq * 64 + 32 * ks + 8 * g);
#pragma unroll
    for (int it = 0; it < 4; ++it) {
        const int idx = tid + NT * it, kk = idx >> 3, ch = idx & 7;
        *(LAS u32x4*)(Ks + (kk * 72 + ch * 8) * 2) = kv[it]; *(LAS u32x4*)(Vs + (kk * 72 + ch * 8) * 2) = vv[it];
    }
    __syncthreads();
    const float sink = sinks[hq];
#pragma unroll
    for (int sb = 0; sb < 4; ++sb) {
        const int i0 = 64 * (w & 1) + 16 * sb, qrow = b * SEQ + blk * 128 + i0 + c;
        const int tile0 = (i0 >> 4) < 6 ? (i0 >> 4) : 6;
        f32x4 o[4]; float inv;
        attn16(Ks, Vs, tile0, (blk - 1) * 128, qa[sb], blk * 128 + i0 + c, sink, o, inv, lane);
#pragma unroll
        for (int mt = 0; mt < 4; ++mt) { u32x2 wv; wv.x = pk2(o[mt].x * inv, o[mt].y * inv); wv.y = pk2(o[mt].z * inv, o[mt].w * inv); *(u32x2*)(OG + (size_t)qrow * D + hq * 64 + 16 * mt + 4 * g) = wv; }
    }
    __syncthreads();
}

__device__ __forceinline__ void attn_sample_load(LAS unsigned char* wl, const bf16* P, const float* ck, const float* cv, int item, int qw, int lane) {
    asm volatile("" : "+v"(lane));
    const int b = item >> 2, kvh = item & 3;
    LAS unsigned char* Ks = wl; LAS unsigned char* Vs = wl + 23040;
    f32x4 kx[8], vx[8];
#pragma unroll
    for (int it = 0; it < 8; ++it) {
        const int idx = lane + 64 * it, l = 32 * qw + (idx >> 4), c4 = idx & 15;
        const size_t off = (((size_t)b * WIN + l) * HKV + kvh) * DH + c4 * 4;
        kx[it] = __builtin_nontemporal_load((const f32x4*)(ck + off)); vx[it] = __builtin_nontemporal_load((const f32x4*)(cv + off));
    }
#pragma unroll
    for (int it = 0; it < 8; ++it) {
        const int idx = lane + 64 * it, l = 32 * qw + (idx >> 4), c4 = idx & 15;
        u32x2 kw, vw; kw.x = pk2(kx[it].x, kx[it].y); kw.y = pk2(kx[it].z, kx[it].w); vw.x = pk2(vx[it].x, vx[it].y); vw.y = pk2(vx[it].z, vx[it].w);
        *(LAS u32x2*)(Ks + (l * 72 + c4 * 4) * 2) = kw; *(LAS u32x2*)(Vs + (l * 72 + c4 * 4) * 2) = vw;
    }
    {
        const int idx = lane + 64 * qw, rr = idx >> 3, ch = idx & 7;
        u32x4 kv = {0u, 0u, 0u, 0u}, vv = {0u, 0u, 0u, 0u};
        if (rr < DECT) { const bf16* src = P + (size_t)(MP + b * DECT + rr) * SN + kvh * 64 + ch * 8; kv = *(const u32x4*)(src + 1024); vv = *(const u32x4*)(src + 1280); }
        *(LAS u32x4*)(Ks + ((128 + rr) * 72 + ch * 8) * 2) = kv; *(LAS u32x4*)(Vs + ((128 + rr) * 72 + ch * 8) * 2) = vv;
    }
}
__device__ __forceinline__ void attn_sample_compute(LAS unsigned char* wl, const bf16* P, bf16* OG, const float* sinks, int item, int lane) {
    asm volatile("" : "+v"(lane));
    const int c = lane & 15, g = lane >> 4;
    const int b = item >> 2, kvh = item & 3;
    LAS unsigned char* Ks = wl; LAS unsigned char* Vs = wl + 23040;
    const int t = c >> 2, hq = kvh * 4 + (c & 3), qrow = MP + b * DECT + t;
    bf16x8 qf[2];
#pragma unroll
    for (int ks = 0; ks < 2; ++ks) qf[ks] = *(const bf16x8*)(P + (size_t)qrow * SN + hq * 64 + 32 * ks + 8 * g);
    f32x4 o[4]; float inv;
    attn16(Ks, Vs, 0, PAST - WIN, qf, PAST + t, sinks[hq], o, inv, lane);
#pragma unroll
    for (int mt = 0; mt < 4; ++mt) { u32x2 wv; wv.x = pk2(o[mt].x * inv, o[mt].y * inv); wv.y = pk2(o[mt].z * inv, o[mt].w * inv); *(u32x2*)(OG + (size_t)qrow * D + hq * 64 + 16 * mt + 4 * g) = wv; }
}

#define SB() __builtin_amdgcn_sched_barrier(0)
#define LBAR() do { asm volatile("s_waitcnt lgkmcnt(0)" ::: "memory"); __builtin_amdgcn_s_barrier(); asm volatile("" ::: "memory"); } while (0)
__device__ __forceinline__ void ret_prompt_item(LAS unsigned char* lds, const bf16* P, bf16* OG, float* GN, float* state_out, int item, int tid) {
    asm volatile("" : "+v"(tid));
    const int lane = tid & 63, w = __builtin_amdgcn_readfirstlane(tid >> 6), c = lane & 15, g = lane >> 4, q4 = c >> 2, p4 = c & 3;
    const int bh = 2 * (item & 7) + ((item >> 3) >> 3), es = (item >> 3) & 7, b = bh >> 2, h = bh & 3;
    const float lg = uni(log2f(1.0f - exp2f(-5.0f - (float)h)));
    LAS unsigned char* Ks = lds; LAS unsigned char* Vs = lds + 69632; LAS unsigned char* Vd = Vs + 18432; LAS unsigned char* Ss = Vd + 18432;
    for (int i = tid; i < 34816 / 16; i += NT) ((LAS u32x4*)Ss)[i] = (u32x4){0u, 0u, 0u, 0u};
    f32x4 Sacc[2][4];
#pragma unroll
    for (int md = 0; md < 2; ++md)
#pragma unroll
        for (int ne = 0; ne < 4; ++ne) Sacc[md][ne] = (f32x4){0.f, 0.f, 0.f, 0.f};
    const float cdec = uni(exp2f(128.0f * lg));
    const float gi0 = exp2f((float)(16 * w + c) * lg), g16i = uni(exp2f(-16.0f * lg)), gam1 = uni(exp2f(lg));
    const float gj0 = exp2f(-(float)(4 * g) * lg);
    float gru[4], tfac[4];
#pragma unroll
    for (int r = 0; r < 4; ++r) { gru[r] = uni(exp2f(-(float)r * lg)); tfac[r] = uni(exp2f(-32.0f * (float)r * lg)); }
    const bf16* Pk = P + (size_t)(b * SEQ) * RN + 1024 + h * 256; const bf16* Pv = P + (size_t)(b * SEQ) * RN + 2048 + h * 512 + es * 64; const bf16* Pq = P + (size_t)(b * SEQ) * RN + h * 256;
#define kp (Pk + ((unsigned)(tl_ >> 5) * RN + (tl_ & 31) * 8))
#define vp (Pv + ((unsigned)(tl_ >> 3) * RN + (tl_ & 7) * 8))
#define qp (Pq + ((unsigned)(tl_ & 0x1cf) * 0 + (unsigned)(16 * (tl_ >> 6) + (tl_ & 15)) * RN + 8 * ((tl_ >> 4) & 3)))
    int tl_ = tid;
    const float g64i = uni(exp2f(-64.0f * lg));
    u32x4 kpre[8], vpre[2]; bf16x8 qf[8];
#pragma unroll
    for (int it = 0; it < 8; ++it) kpre[it] = *(const u32x4*)(kp + (size_t)(16 * it) * RN);
#pragma unroll
    for (int it = 0; it < 2; ++it) vpre[it] = *(const u32x4*)(vp + (size_t)(64 * it) * RN);
#pragma unroll
    for (int ks = 0; ks < 8; ++ks) qf[ks] = *(const bf16x8*)(qp + 32 * ks);
#pragma unroll 1
    for (int n = 0; n < SEQ / 128; ++n) {
        LBAR();
        float gi = gi0; int ib = 16 * w + c; tl_ = tid; asm volatile("" : "+v"(gi), "+v"(ib), "+v"(tl_));
#pragma unroll
        for (int it = 0; it < 8; ++it) *(LAS u32x4*)(Ks + (((tid >> 5) + 16 * it) * 272 + (tid & 31) * 8) * 2) = kpre[it];
#pragma unroll
        for (int it = 0; it < 2; ++it) { const u32x4 v = vpre[it]; const int j = (tid >> 3) + 64 * it; const float vf0 = exp2f((float)(127 - (tl_ >> 3)) * lg); const float f = it ? vf0 * g64i : vf0;
            *(LAS u32x4*)(Vs + (j * 72 + (tid & 7) * 8) * 2) = v;
            u32x4 d; d.x = pk2(bflo(v.x) * f, bfhi(v.x) * f); d.y = pk2(bflo(v.y) * f, bfhi(v.y) * f); d.z = pk2(bflo(v.z) * f, bfhi(v.z) * f); d.w = pk2(bflo(v.w) * f, bfhi(v.w) * f);
            *(LAS u32x4*)(Vd + (j * 72 + (tid & 7) * 8) * 2) = d; }
        const int qrow = b * SEQ + n * 128 + 16 * w + c;
        const size_t adv = (size_t)(n + 1 < SEQ / 128 ? n + 1 : n) * 128 * RN;
        {
#pragma unroll
            for (int it = 0; it < 8; ++it) kpre[it] = *(const u32x4*)(kp + adv + (size_t)(16 * it) * RN);
#pragma unroll
            for (int it = 0; it < 2; ++it) vpre[it] = *(const u32x4*)(vp + adv + (size_t)(64 * it) * RN);
        }
        LBAR();
        f32x4 oT[4];
#pragma unroll
        for (int mt = 0; mt < 4; ++mt) {
            f32x4 acc = {0.f, 0.f, 0.f, 0.f};
#pragma unroll
            for (int kh = 0; kh < 2; ++kh) {
                bf16x8 Ab[4];
#pragma unroll
                for (int ks = 0; ks < 4; ++ks) Ab[ks] = *(LAS const bf16x8*)(Ss + ((16 * mt + c) * 272 + 32 * (4 * kh + ks) + 8 * g) * 2);
                SB();
#pragma unroll
                for (int ks = 0; ks < 4; ++ks) acc = MFMA16(Ab[ks], qf[4 * kh + ks], acc);
                SB();
            }
            oT[mt] = acc * (gi * gam1);
        }
#pragma unroll
        for (int tp = 0; tp < 4; ++tp) {
            if (2 * tp <= w) {
                bf16x8 A0[4], A1[4]; s16x4 vlo[4], vhi[4];
                f32x4 sA = {0.f, 0.f, 0.f, 0.f}, sB = {0.f, 0.f, 0.f, 0.f};
#pragma unroll
                for (int kh = 0; kh < 2; ++kh) {
#pragma unroll
                    for (int ks = 0; ks < 4; ++ks) {
                        A0[ks] = *(LAS const bf16x8*)(Ks + ((32 * tp + c) * 272 + 32 * (4 * kh + ks) + 8 * g) * 2);
                        A1[ks] = *(LAS const bf16x8*)(Ks + ((32 * tp + 16 + c) * 272 + 32 * (4 * kh + ks) + 8 * g) * 2);
                    }
                    SB();
#pragma unroll
                    for (int ks = 0; ks < 4; ++ks) { sA = MFMA16(A0[ks], qf[4 * kh + ks], sA); sB = MFMA16(A1[ks], qf[4 * kh + ks], sB); }
                    SB();
                }
#pragma unroll
                for (int mt = 0; mt < 4; ++mt) {
                    vlo[mt] = vtr(Vs + ((32 * tp + 4 * g + q4) * 72 + 16 * mt + 4 * p4) * 2);
                    vhi[mt] = vtr(Vs + ((32 * tp + 16 + 4 * g + q4) * 72 + 16 * mt + 4 * p4) * 2);
                }
                const float gt = gi * tfac[tp] * gj0;
#pragma unroll
                for (int r = 0; r < 4; ++r) {
                    const int dj = ib - (32 * tp + 4 * g + r);
                    const float fa = gt * gru[r];
                    sA[r] = dj >= 0 ? sA[r] * fa : 0.f;
                    sB[r] = dj >= 16 ? sB[r] * (fa * g16i) : 0.f;
                }
                const bf16x8 pf = packp(sA, sB);
#pragma unroll
                for (int mt = 0; mt < 4; ++mt) oT[mt] = MFMA16(cat8(vlo[mt], vhi[mt]), pf, oT[mt]);
                SB();
            }
        }
        {
            float ss = 0.f;
#pragma unroll
            for (int mt = 0; mt < 4; ++mt) { ss += dot4(oT[mt]); u32x2 wv; wv.x = pk2(oT[mt].x, oT[mt].y); wv.y = pk2(oT[mt].z, oT[mt].w); *(u32x2*)(OG + (size_t)qrow * RO + h * 512 + es * 64 + 16 * mt + 4 * g) = wv; }
            ss += __shfl_xor(ss, 16); ss += __shfl_xor(ss, 32);
            if (g == 0) GN[(size_t)qrow * 32 + h * 8 + es] = ss;
        }
        tl_ = tid; asm volatile("" : "+v"(tl_));
        {
#pragma unroll
            for (int ks = 0; ks < 8; ++ks) qf[ks] = *(const bf16x8*)(qp + adv + 32 * ks);
        }
#pragma unroll
        for (int md = 0; md < 2; ++md)
#pragma unroll
            for (int ne = 0; ne < 4; ++ne) Sacc[md][ne] = Sacc[md][ne] * cdec;
#pragma unroll
        for (int kj = 0; kj < 4; ++kj) {
            s16x4 tl[6], th[6];
#pragma unroll
            for (int md = 0; md < 2; ++md) {
                tl[md] = vtr(Ks + ((32 * kj + 8 * g + q4) * 272 + 32 * w + 16 * md + 4 * p4) * 2); th[md] = vtr(Ks + ((32 * kj + 8 * g + 4 + q4) * 272 + 32 * w + 16 * md + 4 * p4) * 2); }
#pragma unroll
            for (int ne = 0; ne < 4; ++ne) {
                tl[2 + ne] = vtr(Vd + ((32 * kj + 8 * g + q4) * 72 + 16 * ne + 4 * p4) * 2); th[2 + ne] = vtr(Vd + ((32 * kj + 8 * g + 4 + q4) * 72 + 16 * ne + 4 * p4) * 2); }
            SB();
#pragma unroll
            for (int md = 0; md < 2; ++md)
#pragma unroll
                for (int ne = 0; ne < 4; ++ne) Sacc[md][ne] = MFMA16(cat8(tl[md], th[md]), cat8(tl[2 + ne], th[2 + ne]), Sacc[md][ne]);
            SB();
        }
        LBAR();
#pragma unroll
        for (int md = 0; md < 2; ++md)
#pragma unroll
            for (int ne = 0; ne < 4; ++ne) { u32x2 wv; wv.x = pk2(Sacc[md][ne].x, Sacc[md][ne].y); wv.y = pk2(Sacc[md][ne].z, Sacc[md][ne].w);
                *(LAS u32x2*)(Ss + ((16 * ne + c) * 272 + 32 * w + 16 * md + 4 * g) * 2) = wv; }
    }
#pragma unroll
    for (int md = 0; md < 2; ++md)
#pragma unroll
        for (int ne = 0; ne < 4; ++ne)
#pragma unroll
            for (int r = 0; r < 4; ++r) __builtin_nontemporal_store(Sacc[md][ne][r], state_out + ((size_t)(b * RH + h) * RDK + 32 * w + 16 * md + 4 * g + r) * RDV + es * 64 + 16 * ne + c);
    __syncthreads();
}
#undef kp
#undef vp
#undef qp

__device__ __forceinline__ void ret_sample_item(LAS unsigned char* lds, const bf16* P, bf16* OG, const float* S0, float* S1, int item, int tid) {
    asm volatile("" : "+v"(tid));
    const int lane = tid & 63, w = tid >> 6;
    const int b = item >> 2, h = item & 3, R0 = MP + b * DECT;
    const float lg = log2f(1.0f - exp2f(-5.0f - (float)h));
    LAS float* qs = (LAS float*)lds; LAS float* ks = qs + 1024; LAS float* vs = ks + 1024; LAS float* sc = vs + 2048; LAS float* red = sc + 64; LAS float* nrm = red + 8192;
#pragma unroll
    for (int it = 0; it < 2; ++it) { const int e = tid + NT * it, i = e >> 8, d = e & 255;
        qs[e] = bf2f(P[(size_t)(R0 + i) * RN + h * 256 + d]); ks[e] = bf2f(P[(size_t)(R0 + i) * RN + 1024 + h * 256 + d]) * exp2f((float)(3 - i) * lg); }
#pragma unroll
    for (int i = 0; i < 4; ++i) vs[i * 512 + tid] = bf2f(P[(size_t)(R0 + i) * RN + 2048 + h * 512 + tid]);
    __syncthreads();
#pragma unroll
    for (int k = 0; k < 2; ++k) { const int en = 2 * w + k, i = en >> 2, j = en & 3;
        float pt = 0.f;
#pragma unroll
        for (int dd = 0; dd < 4; ++dd) pt += qs[i * 256 + lane + 64 * dd] * ks[j * 256 + lane + 64 * dd];
        pt = wave_sum(pt);
        if (lane == 0) sc[en] = j <= i ? pt * exp2f((float)(i - 3) * lg) : 0.f; }
    const int e4 = (tid & 127) * 4, dq = tid >> 7;
    f32x4 v[4], cacc[4];
#pragma unroll
    for (int j = 0; j < 4; ++j) { v[j] = *(LAS const f32x4*)(vs + j * 512 + e4); cacc[j] = (f32x4){0.f, 0.f, 0.f, 0.f}; }
    const float c4 = exp2f(4.0f * lg);
    const size_t sbase = ((size_t)(b * RH + h) * RDK + dq * 64) * RDV + e4;
    const float* sp = S0 + sbase; float* dp = S1 + sbase;
    {
        f32x4 sa[8], sb[8];
#define RS_LOAD(dst, r0) do { _Pragma("unroll") for (int u = 0; u < 8; ++u) dst[u] = __builtin_nontemporal_load((const f32x4*)(sp + (size_t)((r0) + u) * RDV)); } while (0)
#define RS_USE(src, r0) do { _Pragma("unroll") for (int u = 0; u < 8; ++u) { const int d = dq * 64 + (r0) + u; const f32x4 sv = src[u]; f32x4 sf = sv * c4; \
            _Pragma("unroll") for (int j = 0; j < 4; ++j) { cacc[j] += sv * qs[j * 256 + d]; sf += v[j] * ks[j * 256 + d]; } \
            __builtin_nontemporal_store(sf, (f32x4*)(dp + (size_t)((r0) + u) * RDV)); } } while (0)
        RS_LOAD(sa, 0);
#pragma unroll
        for (int it = 0; it < 4; ++it) {
            RS_LOAD(sb, 16 * it + 8);
            SB();
            RS_USE(sa, 16 * it);
            SB();
            RS_LOAD(sa, it < 3 ? 16 * it + 16 : 48);
            SB();
            RS_USE(sb, 16 * it + 8);
            SB();
        }
#undef RS_LOAD
#undef RS_USE
    }
#pragma unroll
    for (int i = 0; i < 4; ++i) *(LAS f32x4*)(red + (dq * 4 + i) * 512 + e4) = cacc[i];
    __syncthreads();
    float o[4];
#pragma unroll
    for (int i = 0; i < 4; ++i) {
        float cr = (red[(0 * 4 + i) * 512 + tid] + red[(1 * 4 + i) * 512 + tid]) + (red[(2 * 4 + i) * 512 + tid] + red[(3 * 4 + i) * 512 + tid]);
        cr *= exp2f((float)(i + 1) * lg);
#pragma unroll
        for (int j = 0; j < 4; ++j) cr += sc[i * 4 + j] * vs[j * 512 + tid];
        o[i] = cr;
        const float s2 = wave_sum(cr * cr);
        if (lane == 0) nrm[w * 4 + i] = s2;
    }
    __syncthreads();
#pragma unroll
    for (int i = 0; i < 4; ++i) {
        float tot = 0.f;
#pragma unroll
        for (int ww = 0; ww < 8; ++ww) tot += nrm[ww * 4 + i];
        const float rs = rsqrtf(tot * (1.0f / 512.0f) + EPS);
        const float sg = bf2f(P[(size_t)(R0 + i) * RN + 4096 + h * 512 + tid]);
        OG[(size_t)(R0 + i) * RO + h * 512 + tid] = (bf16)(pk2(o[i] * rs * sg, 0.f) & 0xffffu);
    }
    __syncthreads();
}

__device__ __forceinline__ void ret_normalize(const bf16* P, bf16* OG, const float* GN, int bid, int G, int tid) {
    asm volatile("" : "+v"(tid));
    const int lane = tid & 63, gw = bid * 8 + (tid >> 6), NGW = G * 8;
    for (int idx0 = gw * 4; idx0 < MP * RH; idx0 += NGW * 4) {
        const int row = idx0 >> 2;
        u32x4 o[4], sg[4]; f32x4 ga[4], gb[4];
#pragma unroll
        for (int h = 0; h < 4; ++h) {
            const f32x4* gp = (const f32x4*)(GN + (size_t)row * 32 + h * 8); ga[h] = gp[0]; gb[h] = gp[1];
            o[h] = __builtin_nontemporal_load((const u32x4*)(OG + (size_t)row * RO + h * 512) + lane); sg[h] = __builtin_nontemporal_load((const u32x4*)(P + (size_t)row * RN + 4096 + h * 512) + lane);
        }
#pragma unroll
        for (int h = 0; h < 4; ++h) {
            const float rs = rsqrtf((((ga[h].x + ga[h].y) + (ga[h].z + ga[h].w)) + ((gb[h].x + gb[h].y) + (gb[h].z + gb[h].w))) * (1.0f / 512.0f) + EPS);
            u32x4 r;
            r.x = pk2(bflo(o[h].x) * rs * bflo(sg[h].x), bfhi(o[h].x) * rs * bfhi(sg[h].x)); r.y = pk2(bflo(o[h].y) * rs * bflo(sg[h].y), bfhi(o[h].y) * rs * bfhi(sg[h].y));
            r.z = pk2(bflo(o[h].z) * rs * bflo(sg[h].z), bfhi(o[h].z) * rs * bfhi(sg[h].z)); r.w = pk2(bflo(o[h].w) * rs * bflo(sg[h].w), bfhi(o[h].w) * rs * bfhi(sg[h].w));
            *((u32x4*)(OG + (size_t)row * RO + h * 512) + lane) = r;
        }
    }
}

__device__ __forceinline__ void mini_res_tile(LAS unsigned char* lds, const bf16* A, const bf16* Bt, int K, const float* Xin, float* X, bf16* XB, float* SSQ, int tile, int tid) {
    asm volatile("" : "+v"(tid));
    const int lane = tid & 63, w = __builtin_amdgcn_readfirstlane(tid >> 6), c = lane & 15, g = lane >> 4;
    const int rb = tile >> 4, cb = tile & 15, kw = K >> 3, k0 = w * kw;
    f32x4 acc[2][4];
#pragma unroll
    for (int m = 0; m < 2; ++m)
#pragma unroll
        for (int n = 0; n < 4; ++n) acc[m][n] = (f32x4){0.f, 0.f, 0.f, 0.f};
    const bf16* ap = A + (size_t)(MP + 32 * rb + c) * K + k0 + 8 * g;
    const bf16* bp = Bt + (size_t)(64 * cb + c) * K + k0 + 8 * g;
#pragma unroll 8
    for (int ks = 0; ks < kw; ks += 32) {
        bf16x8 a[2], b[4];
#pragma unroll
        for (int m = 0; m < 2; ++m) a[m] = *(const bf16x8*)(ap + (size_t)(16 * m) * K + ks);
#pragma unroll
        for (int n = 0; n < 4; ++n) b[n] = *(const bf16x8*)(bp + (size_t)(16 * n) * K + ks);
#pragma unroll
        for (int m = 0; m < 2; ++m)
#pragma unroll
            for (int n = 0; n < 4; ++n) acc[m][n] = MFMA16(a[m], b[n], acc[m][n]);
    }
    LAS float* red = (LAS float*)lds;
#pragma unroll
    for (int m = 0; m < 2; ++m)
#pragma unroll
        for (int n = 0; n < 4; ++n)
#pragma unroll
            for (int r = 0; r < 4; ++r) red[(w * 32 + 16 * m + 4 * g + r) * 68 + 16 * n + c] = acc[m][n][r];
    __syncthreads();
    const int row = tid >> 4, cq = tid & 15;
    f32x4 v = {0.f, 0.f, 0.f, 0.f};
#pragma unroll
    for (int ww = 0; ww < 8; ++ww) v += *(LAS const f32x4*)(red + (ww * 32 + row) * 68 + 4 * cq);
    const int grow = MP + 32 * rb + row, col = 64 * cb + 4 * cq;
    float* xp = X + (size_t)grow * D + col;
    const f32x4 x = *(const f32x4*)(Xin + (size_t)grow * D + col) + v;
    *(f32x4*)xp = x;
    u32x2 wv; wv.x = pk2(x.x, x.y); wv.y = pk2(x.z, x.w); *(u32x2*)(XB + (size_t)grow * D + col) = wv;
    float ss = dot4(x);
    ss += __shfl_xor(ss, 1); ss += __shfl_xor(ss, 2); ss += __shfl_xor(ss, 4); ss += __shfl_xor(ss, 8);
    if (cq == 0) SSQ[(size_t)grow * 16 + cb] = ss;
    __syncthreads();
}

#define KAS __attribute__((address_space(4)))
#define BAR_LDS_OFF (LDS_BYTES - 64)
#define GSYNC_CG() do { __threadfence(); grid.sync(); __threadfence(); } while (0)
#define GSYNC() do { XcdBarrier xb_; xb_.bar = (unsigned*)((const KAS Args*)__builtin_amdgcn_kernarg_segment_ptr())->ws; xb_.x = xb_xcc_id(); xb_.st = (volatile LAS unsigned*)(lds + BAR_LDS_OFF); xcd_barrier(xb_); } while (0)
#define PHASE_PTRS() const KAS Args* ap = (const KAS Args*)__builtin_amdgcn_kernarg_segment_ptr(); asm volatile("" : "+s"(ap)); unsigned char* ws = ap->ws; float* X = ap->out; \
    const int tid = threadIdx.x, bid = blockIdx.x, G = gridDim.x; (void)tid; (void)bid; (void)G; \
    bf16* XB = (bf16*)(ws + WS_XB); float* SSQ = (float*)(ws + WS_SSQ); bf16* PROJ = (bf16*)(ws + WS_PROJ); bf16* OG = (bf16*)(ws + WS_OG); bf16* ACT = (bf16*)(ws + WS_ACT); \
    (void)XB; (void)SSQ; (void)PROJ; (void)OG; (void)ACT; (void)X
template <int L> __device__ __forceinline__ void run_layer(cg::grid_group& grid, LAS unsigned char* lds) {
    constexpr bool isret = !(L & 1); constexpr int li = L >> 1;
#ifndef SKIP_G1
#ifndef SKIP_G1R
        if constexpr (isret) {
            PHASE_PTRS();
            const int mrows = G >= 256 ? MP : M;
            pg8::Gemm g{XB, (const bf16*)(ws + WS_RIN) + (size_t)li * RN * D, mrows, RN, D}; pg8::StaticOrder S; S.init(mrows, RN, G, bid);
            EpiRetIn E{PROJ, SSQ, (const float*)(ws + WS_TABR), 0};
            pg8::gemm_phase<EpiRetIn, pg8::StaticOrder, true, true>(lds, g, S, E);
        }
#endif
#ifndef SKIP_G1S
        if constexpr (!isret) {
            PHASE_PTRS();
            pg8::Gemm g{XB, (const bf16*)(ws + WS_QKV) + (size_t)li * SN * D, M, SN, D}; pg8::StaticOrder S; S.init(M, SN, G, bid);
            EpiSwaQkv E{PROJ, SSQ, (const float*)(ws + WS_TABS), ap->in[10] + li * DH, ap->in[11] + li * DH, X + O_CKP + li * CP_L, X + O_CVP + li * CP_L, X + O_CKS + li * CS_L, X + O_CVS + li * CS_L};
            pg8::gemm_phase<EpiSwaQkv, pg8::StaticOrder, true, true>(lds, g, S, E);
        }
#endif
#endif
        GSYNC();
        if constexpr (isret) {
            for (int rep = 0; rep < REP_RET; ++rep) {
            PHASE_PTRS();
            float* GN = (float*)(ws + WS_GN);
            const int npb = G >= 256 ? 128 : G;
#ifndef SKIP_RETP
            if (bid < npb) for (int it = bid; it < NB * RH * 8; it += npb) ret_prompt_item(lds, PROJ, OG, GN, X + O_SRP + li * SRP_L, it, tid);
#endif
#ifndef SKIP_RETS
            if (G >= 256 && bid >= 128) {
                pg8::Gemm g{XB + (size_t)MP * D, (const bf16*)(ws + WS_RIN) + (size_t)li * RN * D, MS, RN, D}; pg8::StaticOrder S; S.init(MS, RN, G - 128, bid - 128);
                EpiRetIn E{PROJ, SSQ, (const float*)(ws + WS_TABR), MP};
                pg8::gemm_phase<EpiRetIn, pg8::StaticOrder, true, true>(lds, g, S, E);
                sub_barrier_once((unsigned*)(ws + 16384) + 64 * li, (unsigned)(G - 128));
            }
            if (G >= 256) { if (bid >= 128) for (int it = bid - 128; it < DECB * RH; it += G - 128) ret_sample_item(lds, PROJ, OG, ap->in[2] + li * SRS_L, X + O_SRS + li * SRS_L, it, tid); }
            else for (int it = bid; it < DECB * RH; it += G) ret_sample_item(lds, PROJ, OG, ap->in[2] + li * SRS_L, X + O_SRS + li * SRS_L, it, tid);
#endif
            }
            GSYNC();
            {
            PHASE_PTRS();
            ret_normalize(PROJ, OG, (const float*)(ws + WS_GN), bid, G, tid);
            }
        } else {
#ifndef SKIP_ATTN
            for (int rep = 0; rep < REP_ATTN; ++rep) {
            PHASE_PTRS();
            const float* sinks = ap->in[12] + li * 16;
            for (int it = bid; it < NB * 32 * HKV; it += G) attn_prompt_item(lds, PROJ, OG, sinks, it, tid);
            const int wave = __builtin_amdgcn_readfirstlane(tid >> 6);
            for (int it0 = bid * 2; it0 < DECB * HKV; it0 += 2 * G) {
                const int it = it0 + (wave >> 2);
                attn_sample_load(lds + (wave >> 2) * 46080, PROJ, ap->in[3] + li * CS_L, ap->in[4] + li * CS_L, it, wave & 3, tid & 63);
                __syncthreads();
                if ((wave & 3) == 0) attn_sample_compute(lds + (wave >> 2) * 46080, PROJ, OG, sinks, it, tid & 63);
                __syncthreads();
            }
            __syncthreads();
            }
#endif
            __syncthreads();
        }
        GSYNC();
#ifndef SKIP_G2
        {
            PHASE_PTRS();
            pg8::Gemm g{OG, isret ? (const bf16*)(ws + WS_ROUT) + (size_t)li * D * RO : (const bf16*)(ws + WS_WO) + (size_t)li * D * D, MP, D, isret ? RO : D};
            pg8::StaticOrder S; S.init(MP, D, G, bid);
            const float* Xp = L == 0 ? ap->in[0] : X; const float* Xs = L == 0 ? ap->in[1] - (size_t)MP * D : X;
            EpiRes E{Xp, X, XB, SSQ};
            pg8::gemm_phase<EpiRes, pg8::StaticOrder, true, true>(lds, g, S, E);
            for (int t = bid; t < 256; t += G) mini_res_tile(lds, g.A, g.Bt, g.K, Xs, X, XB, SSQ, t, tid);
        }
#endif
        GSYNC();
#ifndef SKIP_G3
        {
            PHASE_PTRS();
            pg8::Gemm g{XB, (const bf16*)(ws + WS_UP) + (size_t)L * FF * D, M, FF, D}; pg8::StaticOrder S; S.init(M, FF, G, bid);
            EpiUp E{ACT, SSQ};
            pg8::gemm_phase<EpiUp, pg8::StaticOrder, true, true>(lds, g, S, E);
            if constexpr (L == 3) {
                const int busy = (M / 256) * (FF / 256) % G;
                if (bid >= busy) copy_sample_caches(ap->in, X, (bid - busy) * NT + tid, (G - busy) * NT);
            }
            if constexpr (L < 3) {
                const int busy = (M / 256) * (FF / 256) % G;
                if (bid >= busy && busy > 0) convert_layer_weights(ap->in, ws, L + 1, (LAS float*)(lds + (tid >> 6) * 16384), (bid - busy) * 8 + (tid >> 6), (G - busy) * 8, tid & 63);
                else if (busy == 0) convert_layer_weights(ap->in, ws, L + 1, (LAS float*)(lds + (tid >> 6) * 16384), bid * 8 + (tid >> 6), G * 8, tid & 63);
                __syncthreads();
            }
        }
#endif
        GSYNC();
#ifndef SKIP_G4
        {
            PHASE_PTRS();
            pg8::Gemm g{ACT, (const bf16*)(ws + WS_DN) + (size_t)L * D * FF, MP, D, FF}; pg8::StaticOrder S; S.init(MP, D, G, bid);
            EpiRes E{X, X, XB, SSQ};
            pg8::gemm_phase<EpiRes, pg8::StaticOrder, true, true>(lds, g, S, E);
            for (int t = bid; t < 256; t += G) mini_res_tile(lds, g.A, g.Bt, g.K, X, X, XB, SSQ, t, tid);
        }
#endif
        if (L < 3) GSYNC();
}

__global__ void __launch_bounds__(NT, 2) hybrid_fwd(Args a) {
    extern __shared__ __attribute__((aligned(16))) unsigned char lds_raw[];
    LAS unsigned char* lds = (LAS unsigned char*)lds_raw;
    cg::grid_group grid = cg::this_grid();
    grid.sync();
    if (threadIdx.x < 16) ((LAS unsigned*)(lds + BAR_LDS_OFF))[threadIdx.x] = 0u;
    __syncthreads();
    (void)xcd_barrier_post((unsigned*)a.ws, (volatile LAS unsigned*)(lds + BAR_LDS_OFF));
#ifndef SKIP_P0
    for (int rep = 0; rep < REP_P0; ++rep) { p0_prologue(a, lds, blockIdx.x, gridDim.x, threadIdx.x); __syncthreads(); }
#endif
    GSYNC();

    run_layer<0>(grid, lds); run_layer<1>(grid, lds); run_layer<2>(grid, lds); run_layer<3>(grid, lds);
}

extern "C" void kernel_launch(void* const* d_in, const int* in_sizes, int n_in, void* d_out, int out_size, void* d_ws, size_t ws_size, hipStream_t stream) {
    static int grid = 0;
    if (grid == 0) {
        if (n_in != 16 || ws_size < WS_END) { fprintf(stderr, "kernel_launch: unexpected inputs (n_in %d, ws %zu)\n", n_in, ws_size); grid = -1; return; }
        int dev = 0, cus = 0, per_cu = 0;
        if (hipGetDevice(&dev) != hipSuccess || hipDeviceGetAttribute(&cus, hipDeviceAttributeMultiprocessorCount, dev) != hipSuccess) { grid = -1; return; }
        if (hipFuncSetAttribute((const void*)hybrid_fwd, hipFuncAttributeMaxDynamicSharedMemorySize, LDS_BYTES) != hipSuccess) { fprintf(stderr, "kernel_launch: hipFuncSetAttribute failed\n"); grid = -1; return; }
        if (hipOccupancyMaxActiveBlocksPerMultiprocessor(&per_cu, (const void*)hybrid_fwd, NT, LDS_BYTES) != hipSuccess || per_cu < 1) { fprintf(stderr, "kernel_launch: occupancy query says %d\n", per_cu); per_cu = 1; }
        (void)hipGetLastError();
        grid = cus;
    }
    if (grid < 0) return;
    if (hipMemsetAsync(d_ws, 0, 32768, stream) != hipSuccess) { fprintf(stderr, "kernel_launch: memset of the barrier words failed\n"); return; }
    Args a{};
    for (int i = 0; i < 16; ++i) a.in[i] = (const float*)d_in[i];
    a.out = (float*)d_out; a.ws = (unsigned char*)d_ws;
    void* args[] = {&a};
    hipError_t e = hipLaunchCooperativeKernel((const void*)hybrid_fwd, dim3(grid), dim3(NT), args, LDS_BYTES, stream);
    if (e != hipSuccess) fprintf(stderr, "kernel_launch: cooperative launch failed: %s (grid %d)\n", hipGetErrorString(e), grid);
}
```
